# Optimizing an MI355X kernel written in HIP

```python
import jax, jax.numpy as jnp
from jax import lax
import numpy as np

D_MODEL = 2048
BATCH = 4
SEQ = 4096
DEPTH = 2

MEM_LEN = 256
EPS = 1e-6

GLA_HEADS = 4
GLA_DK = 128
GLA_DV = 256
GLA_WIDTH = GLA_HEADS * GLA_DV
GLA_KWIDTH = GLA_HEADS * GLA_DK
GLA_CHUNK = 64
GK_RANK = 16
GK_NORMALIZER = 16.0

FOX_HEADS = 8
FOX_DH = 64
FOX_WIDTH = FOX_HEADS * FOX_DH
FOX_BLOCK = 128
FORGET_BIAS_INIT = 3.0

MEM_HEADS = 4
MEM_DH = 128
MEM_WIDTH = MEM_HEADS * MEM_DH

N_BRANCH = 3
MIX_WIDTH = GLA_WIDTH + FOX_WIDTH + MEM_WIDTH

IN_SIZES = (
    GLA_KWIDTH, GLA_KWIDTH, GLA_WIDTH, GLA_WIDTH, GK_RANK,
    FOX_WIDTH, FOX_WIDTH, FOX_WIDTH, FOX_HEADS, FOX_WIDTH,
    MEM_WIDTH, MEM_WIDTH,
    N_BRANCH * D_MODEL,
)
IN_COLS = int(sum(IN_SIZES))
IN_OFFSETS = tuple(int(v) for v in np.cumsum(IN_SIZES)[:-1])
BRANCH_ROWS = (0, GLA_WIDTH, GLA_WIDTH + FOX_WIDTH, MIX_WIDTH)

kernel_name = "hybrid_gla_fox_mem_gated_merge"


def rmsnorm(x, gain):
    xf = x.astype(jnp.float32)
    out = xf * lax.rsqrt(jnp.mean(xf * xf, axis=-1, keepdims=True) + EPS)
    return (out * gain.astype(jnp.float32)).astype(x.dtype)


def gla_chunked(q, k, v, g):
    B, S, H, DK = q.shape
    DV = v.shape[-1]
    C = GLA_CHUNK
    N = S // C

    def to_chunks(t):
        return t.astype(jnp.float32).reshape(B, N, C, H, -1).transpose(1, 0, 3, 2, 4)

    qc, kc, vc, gc = to_chunks(q * (DK ** -0.5)), to_chunks(k), to_chunks(v), to_chunks(g)
    causal = jnp.tril(jnp.ones((C, C), dtype=bool))

    def step(state, inp):
        qi, ki, vi, gi = inp
        b = jnp.cumsum(gi, axis=2)
        o_inter = jnp.einsum('bhcd,bhde->bhce', qi * jnp.exp(b), state)
        diff = b[:, :, :, None, :] - b[:, :, None, :, :]
        decay = jnp.exp(jnp.where(causal[None, None, :, :, None], diff, -jnp.inf))
        scores = jnp.einsum('bhid,bhjd,bhijd->bhij', qi, ki, decay)
        o_intra = jnp.einsum('bhij,bhje->bhie', scores, vi)
        b_last = b[:, :, -1:, :]
        k_dec = ki * jnp.exp(b_last - b)
        state = state * jnp.exp(b_last[:, :, 0, :, None]) + jnp.einsum('bhcd,bhce->bhde', k_dec, vi)
        return state, o_inter + o_intra

    state0 = jnp.zeros((B, H, DK, DV), jnp.float32)
    _, outs = lax.scan(step, state0, (qc, kc, vc, gc))
    return outs.transpose(1, 0, 3, 2, 4).reshape(B, S, H, DV)


def forgetting_attention(q, k, v, log_f):
    B, S, H, Dh = q.shape
    nb = S // FOX_BLOCK
    c = jnp.cumsum(log_f, axis=1).transpose(0, 2, 1)
    kh = k.transpose(0, 2, 1, 3)
    vh = v.transpose(0, 2, 1, 3)
    q_blocks = q.transpose(0, 2, 1, 3).reshape(B, H, nb, FOX_BLOCK, Dh).transpose(2, 0, 1, 3, 4)
    cq_blocks = c.reshape(B, H, nb, FOX_BLOCK).transpose(2, 0, 1, 3)
    key_pos = jnp.arange(S)
    scale = Dh ** -0.5

    def block(args):
        qb, cqb, idx = args
        s = jnp.einsum('bhqd,bhkd->bhqk', qb, kh).astype(jnp.float32) * scale
        s = s + cqb[..., None] - c[:, :, None, :]
        q_pos = idx * FOX_BLOCK + jnp.arange(FOX_BLOCK)
        s = jnp.where(key_pos[None, :] <= q_pos[:, None], s, -jnp.inf)
        p = jax.nn.softmax(s, axis=-1)
        return jnp.einsum('bhqk,bhkd->bhqd', p.astype(vh.dtype), vh)

    out = lax.map(block, (q_blocks, cq_blocks, jnp.arange(nb)))
    return out.transpose(1, 0, 3, 2, 4).reshape(B, S, H, Dh)


def memory_attention(q, mem_k, mem_v):
    s = jnp.einsum('bqhd,bkhd->bhqk', q, mem_k).astype(jnp.float32) * (q.shape[-1] ** -0.5)
    p = jax.nn.softmax(s, axis=-1)
    return jnp.einsum('bhqk,bkhd->bqhd', p.astype(mem_v.dtype), mem_v)


def setup_inputs(seed: int = 0) -> dict:
    key = jax.random.key(seed)
    ks = jax.random.split(key, 16)
    f32 = jnp.float32
    x = jax.random.normal(ks[0], (BATCH, SEQ, D_MODEL), f32)
    mem = jax.random.normal(ks[1], (BATCH, MEM_LEN, D_MODEL), f32)
    norm_gain = 1.0 + 0.02 * jax.random.normal(ks[2], (DEPTH, D_MODEL), f32)
    w_in = jax.random.normal(ks[3], (DEPTH, D_MODEL, IN_COLS), f32) * D_MODEL ** -0.5
    w_gk_up = jax.random.normal(ks[4], (DEPTH, GK_RANK, GLA_KWIDTH), f32) * GK_RANK ** -0.5
    b_gk = 0.1 * jax.random.normal(ks[5], (DEPTH, GLA_KWIDTH), f32)
    gla_norm_gain = 1.0 + 0.02 * jax.random.normal(ks[6], (DEPTH, GLA_DV), f32)
    b_f = FORGET_BIAS_INIT + 0.1 * jax.random.normal(ks[7], (DEPTH, FOX_HEADS), f32)
    mem_norm_gain = 1.0 + 0.02 * jax.random.normal(ks[8], (DEPTH, D_MODEL), f32)
    w_mem_kv = jax.random.normal(ks[9], (DEPTH, D_MODEL, 2 * MEM_WIDTH), f32) * D_MODEL ** -0.5
    kb = jax.random.split(ks[10], 3)
    w_branch = jnp.concatenate([
        jax.random.normal(kb[0], (DEPTH, GLA_WIDTH, D_MODEL), f32) * GLA_WIDTH ** -0.5,
        jax.random.normal(kb[1], (DEPTH, FOX_WIDTH, D_MODEL), f32) * FOX_WIDTH ** -0.5,
        jax.random.normal(kb[2], (DEPTH, MEM_WIDTH, D_MODEL), f32) * MEM_WIDTH ** -0.5,
    ], axis=1)
    w_out = jax.random.normal(ks[11], (DEPTH, D_MODEL, D_MODEL), f32) * D_MODEL ** -0.5
    final_gain = 1.0 + 0.02 * jax.random.normal(ks[12], (D_MODEL,), f32)
    return {"x": x, "mem": mem, "norm_gain": norm_gain, "w_in": w_in, "w_gk_up": w_gk_up,
            "b_gk": b_gk, "gla_norm_gain": gla_norm_gain, "b_f": b_f,
            "mem_norm_gain": mem_norm_gain, "w_mem_kv": w_mem_kv, "w_branch": w_branch,
            "w_out": w_out, "final_gain": final_gain}


def reference(x, mem, norm_gain, w_in, w_gk_up, b_gk, gla_norm_gain, b_f,
              mem_norm_gain, w_mem_kv, w_branch, w_out, final_gain):
    B, S, D = x.shape
    M = mem.shape[1]
    for l in range(DEPTH):
        h = rmsnorm(x, norm_gain[l])
        z = h @ w_in[l]
        (gq, gk_, gv, ggate, gdown, fq, fk, fv, flogit, fgate,
         mq, mgate, merge) = jnp.split(z, IN_OFFSETS, axis=-1)

        gk_log = jax.nn.log_sigmoid((gdown @ w_gk_up[l] + b_gk[l]).astype(jnp.float32)) / GK_NORMALIZER
        o_a = gla_chunked(gq.reshape(B, S, GLA_HEADS, GLA_DK), gk_.reshape(B, S, GLA_HEADS, GLA_DK),
                          gv.reshape(B, S, GLA_HEADS, GLA_DV), gk_log.reshape(B, S, GLA_HEADS, GLA_DK))
        o_a = rmsnorm(o_a, gla_norm_gain[l]).reshape(B, S, GLA_WIDTH).astype(x.dtype)
        o_a = o_a * jax.nn.silu(ggate)

        log_f = jax.nn.log_sigmoid((flogit + b_f[l]).astype(jnp.float32))
        o_b = forgetting_attention(fq.reshape(B, S, FOX_HEADS, FOX_DH), fk.reshape(B, S, FOX_HEADS, FOX_DH),
                                   fv.reshape(B, S, FOX_HEADS, FOX_DH), log_f)
        o_b = o_b.reshape(B, S, FOX_WIDTH) * jax.nn.silu(fgate)

        mkv = rmsnorm(mem, mem_norm_gain[l]) @ w_mem_kv[l]
        mk, mv = jnp.split(mkv, 2, axis=-1)
        o_c = memory_attention(mq.reshape(B, S, MEM_HEADS, MEM_DH), mk.reshape(B, M, MEM_HEADS, MEM_DH),
                               mv.reshape(B, M, MEM_HEADS, MEM_DH))
        o_c = o_c.reshape(B, S, MEM_WIDTH) * jax.nn.silu(mgate)

        gates = jax.nn.sigmoid(merge.reshape(B, S, N_BRANCH, D))
        wb = w_branch[l]
        y = (gates[:, :, 0] * (o_a @ wb[BRANCH_ROWS[0]:BRANCH_ROWS[1]])
             + gates[:, :, 1] * (o_b @ wb[BRANCH_ROWS[1]:BRANCH_ROWS[2]])
             + gates[:, :, 2] * (o_c @ wb[BRANCH_ROWS[2]:BRANCH_ROWS[3]]))
        x = x + y @ w_out[l]
    return rmsnorm(x, final_gain)
```

```cpp
#define PG8_ROT 1
#include <hip/hip_runtime.h>
#include <hip/hip_cooperative_groups.h>
#include <hip/hip_bf16.h>
#include <cstdio>
#include <cstdint>
#include <cmath>
namespace cg = cooperative_groups;
namespace pg8 {
#define PG8_LAS __attribute__((address_space(3)))
typedef unsigned short bf16_t;
typedef short bf16x8 __attribute__((ext_vector_type(8)));
typedef float f32x4 __attribute__((ext_vector_type(4)));
typedef unsigned u32x4 __attribute__((ext_vector_type(4)));
constexpr int BM = 256, BK = 64, HALF = 128, HTB = HALF * BK * 2  , STAGE_BYTES = 8 * HTB, NXCD = 8;
#ifndef PG8_WGM
#define PG8_WGM 4
#endif
constexpr int WGM = PG8_WGM;

__host__ __device__ __forceinline__ int lds_byte(int r, int c) { const int st = (r >> 4) * 2 + (c >> 5), rr = r & 15, cc = c & 31, ob = rr * 64 + cc * 2; return st * 1024 + (ob ^ (((ob >> 9) & 1) << 5)); }
__host__ __device__ __forceinline__ void stage_rc(int b, int& R, int& C) { const int st = b / 1024, sb = b % 1024, swz = sb ^ (((sb >> 9) & 1) << 5); R = (st >> 1) * 16 + swz / 64; C = (st & 1) * 32 + (swz % 64) / 2; }
__host__ __device__ __forceinline__ int perm32(int rho) { const int n = rho >> 4, i = rho & 15; return 8 * (i >> 2) + 4 * n + (i & 3); }

struct Unit { int pm, pn; };
struct Gemm { const bf16_t* A; const bf16_t* Bt; int M, N, K; };

struct StaticOrder {
    int nM, nN, nwg, G, c;
    __host__ __device__ void init(int M, int N, int G_, int c_) { nM = M / BM; nN = N / BM; nwg = nM * nN; G = G_; c = c_; }
    __host__ __device__ bool next(int i, Unit& u) const {
        const long L = (long)i * G + c; if (L >= nwg) return false;
        int wgid = (int)L; const int xcd_ = wgid % NXCD; { const int q = nwg / NXCD, r = nwg % NXCD, xcd = wgid % NXCD, off = wgid / NXCD; wgid = (xcd < r ? xcd * (q + 1) : r * (q + 1) + (xcd - r) * q) + off; }
        const int nig = WGM * nN, gid = wgid / nig, fm = gid * WGM, gsz = (nM - fm) < WGM ? (nM - fm) : WGM;
        u.pm = fm + ((wgid % nig) % gsz); u.pn = (wgid % nig) / gsz;
#ifdef PG8_ROT
        if (nN >= 16) { u.pn += xcd_ * (nN / NXCD); if (u.pn >= nN) u.pn -= nN; }
#endif
        return true;
    }
    __device__ __forceinline__ void a_ready(const Unit&) const {}
    __device__ __forceinline__ void done(const Unit&) const {}
};

__device__ __forceinline__ unsigned cvt_pk_bf16(float lo, float hi) { unsigned r; asm volatile("v_cvt_pk_bf16_f32 %0, %1, %2" : "=v"(r) : "v"(lo), "v"(hi)); return r; }
__device__ __forceinline__ float bf_lo(unsigned u) { return __uint_as_float(u << 16); }
__device__ __forceinline__ float bf_hi(unsigned u) { return __uint_as_float(u & 0xffff0000u); }
__device__ __forceinline__ float fsigmoid(float v) { return __builtin_amdgcn_rcpf(1.f + __expf(-v)); }

struct EpiZ {
    static constexpr bool PERM = true, AFTER_DRAIN = false, HAS_MID = false; static constexpr int MID0 = -1, MID1 = -1;
    bf16_t* Z; int ldz; int kind;
    __device__ __forceinline__ void mid(f32x4 (&acc)[2][2][4][2], const Unit& u, int wr, int wc, int fr, int fq, int which) const {}
    __device__ __forceinline__ void operator()(const f32x4 (&acc)[2][2][4][2], const Unit& u, int wr, int wc, int fr, int fq) const {
        const int row0 = u.pm * BM + wr * 64 + fr;
        int mode = 0; const int pn = u.pn;
        if (kind == 0) {
            if (pn >= 24) mode = 3;
            else if ((pn >= 8 && pn < 12) || pn == 18 || pn == 19 || pn == 22 || pn == 23) mode = 2;
            else if (pn == 12 || pn == 13) mode = 1;
        }
        const int col0 = pn * BM + wc * 32 + 8 * fq;
#pragma unroll
        for (int ai = 0; ai < 2; ++ai)
#pragma unroll
            for (int m = 0; m < 4; ++m) { bf16_t* rowp = Z + (size_t)(row0 + ai * HALF + m * 16) * ldz + col0;
#pragma unroll
                for (int bj = 0; bj < 2; ++bj) { f32x4 v0 = acc[ai][bj][m][0], v1 = acc[ai][bj][m][1];
                    if (mode == 1) { v0 = v0 * 0.18033688011112042f; v1 = v1 * 0.18033688011112042f; }
                    else if (mode == 2) {
#pragma unroll
                        for (int j = 0; j < 4; ++j) { v0[j] = v0[j] * fsigmoid(v0[j]); v1[j] = v1[j] * fsigmoid(v1[j]); } }
                    else if (mode == 3) {
#pragma unroll
                        for (int j = 0; j < 4; ++j) { v0[j] = fsigmoid(v0[j]); v1[j] = fsigmoid(v1[j]); } }
                    u32x4 w; w.x = cvt_pk_bf16(v0[0], v0[1]); w.y = cvt_pk_bf16(v0[2], v0[3]); w.z = cvt_pk_bf16(v1[0], v1[1]); w.w = cvt_pk_bf16(v1[2], v1[3]);
                    *(u32x4*)(rowp + bj * HALF) = w; } }
    }
};

struct EpiY {
    static constexpr bool PERM = true, AFTER_DRAIN = false, HAS_MID = true; static constexpr int MID0 = 16, MID1 = 24;
    bf16_t* Y; const bf16_t* Zg; int ldz;
    __device__ __forceinline__ void mid(f32x4 (&acc)[2][2][4][2], const Unit& u, int wr, int wc, int fr, int fq, int which) const {
        int row0 = u.pm * BM + wr * 64 + fr; asm volatile("" : "+v"(row0)); const int col0 = u.pn * BM + wc * 32 + 8 * fq + which * 2048;
#pragma unroll
        for (int ai = 0; ai < 2; ++ai) {
            u32x4 ga[4][2], gb[4][2];
#pragma unroll
            for (int m = 0; m < 4; ++m) { const bf16_t* rowp = Zg + (size_t)(row0 + ai * HALF + m * 16) * ldz + col0;
#pragma unroll
                for (int bj = 0; bj < 2; ++bj) { ga[m][bj] = *(const u32x4*)(rowp + bj * HALF); gb[m][bj] = *(const u32x4*)(rowp + bj * HALF + 2048); } }
#pragma unroll
            for (int m = 0; m < 4; ++m)
#pragma unroll
                for (int bj = 0; bj < 2; ++bj)
#pragma unroll
                    for (int e = 0; e < 4; ++e) { const float r0 = bf_lo(ga[m][bj][e]) * __builtin_amdgcn_rcpf(fmaxf(bf_lo(gb[m][bj][e]), 1e-30f)), r1 = bf_hi(ga[m][bj][e]) * __builtin_amdgcn_rcpf(fmaxf(bf_hi(gb[m][bj][e]), 1e-30f));
                        acc[ai][bj][m][e >> 1][(e & 1) * 2] *= r0; acc[ai][bj][m][e >> 1][(e & 1) * 2 + 1] *= r1; }
            __builtin_amdgcn_sched_barrier(0); }
        asm volatile("s_waitcnt vmcnt(0)" ::: "memory");
    }
    __device__ __forceinline__ void operator()(const f32x4 (&acc)[2][2][4][2], const Unit& u, int wr, int wc, int fr, int fq) const {
        const int row0 = u.pm * BM + wr * 64 + fr, col0 = u.pn * BM + wc * 32 + 8 * fq;
#pragma unroll
        for (int ai = 0; ai < 2; ++ai)
#pragma unroll
            for (int m = 0; m < 4; ++m) { const size_t r = (size_t)(row0 + ai * HALF + m * 16);
#pragma unroll
                for (int bj = 0; bj < 2; ++bj) { const u32x4 g = *(const u32x4*)(Zg + r * ldz + 4096 + col0 + bj * HALF);
                    const f32x4 a0 = acc[ai][bj][m][0], a1 = acc[ai][bj][m][1]; u32x4 w;
                    w.x = cvt_pk_bf16(a0[0] * bf_lo(g.x), a0[1] * bf_hi(g.x)); w.y = cvt_pk_bf16(a0[2] * bf_lo(g.y), a0[3] * bf_hi(g.y));
                    w.z = cvt_pk_bf16(a1[0] * bf_lo(g.z), a1[1] * bf_hi(g.z)); w.w = cvt_pk_bf16(a1[2] * bf_lo(g.w), a1[3] * bf_hi(g.w));
                    *(u32x4*)(Y + r * 2048 + col0 + bj * HALF) = w; }
                __builtin_amdgcn_sched_barrier(0); }
    }
};

struct EpiX {
    static constexpr bool PERM = false, AFTER_DRAIN = false, HAS_MID = false; static constexpr int MID0 = -1, MID1 = -1;
    const float* Xin; float* Xout; bf16_t* XB; float* ssq;
    __device__ __forceinline__ void mid(f32x4 (&acc)[2][2][4][2], const Unit& u, int wr, int wc, int fr, int fq, int which) const {}
    __device__ __forceinline__ void operator()(const f32x4 (&acc)[2][2][4][2], const Unit& u, int wr, int wc, int fr, int fq) const {
        const int row0 = u.pm * BM + wr * 64 + fr, col0 = u.pn * BM + wc * 32 + 4 * fq;
#pragma unroll
        for (int ai = 0; ai < 2; ++ai)
#pragma unroll
            for (int m = 0; m < 4; ++m) { const int row = row0 + ai * HALF + m * 16; const size_t off = (size_t)row * 2048 + col0; float ss = 0.f;
#pragma unroll
                for (int bj = 0; bj < 2; ++bj)
#pragma unroll
                    for (int n = 0; n < 2; ++n) { const size_t o = off + bj * HALF + n * 16; const f32x4 xo = *(const f32x4*)(Xin + o) + acc[ai][bj][m][n];
                        *(f32x4*)(Xout + o) = xo; ss += (xo[0] * xo[0] + xo[1] * xo[1]) + (xo[2] * xo[2] + xo[3] * xo[3]);
                        if (XB) { unsigned long long w = (unsigned long long)cvt_pk_bf16(xo[0], xo[1]) | ((unsigned long long)cvt_pk_bf16(xo[2], xo[3]) << 32); *(unsigned long long*)(XB + o) = w; } }
                ss += __shfl_xor(ss, 16); ss += __shfl_xor(ss, 32);
                if (fq == 0) atomicAdd(ssq + row, ss); }
    }
};
template <bool FINAL> struct EpiXF {
    static constexpr bool PERM = false, AFTER_DRAIN = false, HAS_MID = false; static constexpr int MID0 = -1, MID1 = -1;
    const float* Xin; float* X; bf16_t* XB; float* ssq; unsigned* cnt; const float* fgain;
    __device__ __forceinline__ void mid(f32x4 (&acc)[2][2][4][2], const Unit& u, int wr, int wc, int fr, int fq, int which) const {}
    __device__ __forceinline__ void operator()(f32x4 (&acc)[2][2][4][2], const Unit& u, int wr, int wc, int fr, int fq) const {
        const int row0 = u.pm * BM + wr * 64 + fr, col0 = u.pn * BM + wc * 32 + 4 * fq;
#pragma unroll
        for (int ai = 0; ai < 2; ++ai)
#pragma unroll
            for (int m = 0; m < 4; ++m) { const int row = row0 + ai * HALF + m * 16; const size_t off = (size_t)row * 2048 + col0; float ss = 0.f;
#pragma unroll
                for (int bj = 0; bj < 2; ++bj)
#pragma unroll
                    for (int n = 0; n < 2; ++n) { const f32x4 xo = *(const f32x4*)(Xin + off + bj * HALF + n * 16) + acc[ai][bj][m][n]; acc[ai][bj][m][n] = xo;
                        if (!FINAL) *(f32x4*)(X + off + bj * HALF + n * 16) = xo;
                        ss += (xo[0] * xo[0] + xo[1] * xo[1]) + (xo[2] * xo[2] + xo[3] * xo[3]); }
                ss += __shfl_xor(ss, 16); ss += __shfl_xor(ss, 32);
                if (fq == 0) atomicAdd(ssq + row, ss); }
        asm volatile("s_waitcnt vmcnt(0)" ::: "memory");
        __builtin_amdgcn_s_barrier();
        if (threadIdx.x == 0) { unsigned* c = cnt + 64 * u.pm; __hip_atomic_fetch_add(c, 1u, __ATOMIC_RELAXED, __HIP_MEMORY_SCOPE_AGENT);
            unsigned sp = 0; while (__hip_atomic_load(c, __ATOMIC_RELAXED, __HIP_MEMORY_SCOPE_AGENT) < 8u && ++sp < (1u << 22)) __builtin_amdgcn_s_sleep(2);
            __builtin_amdgcn_fence(__ATOMIC_ACQUIRE, "agent"); }
        asm volatile("s_waitcnt vmcnt(0) lgkmcnt(0)" ::: "memory");
        __builtin_amdgcn_s_barrier();
        asm volatile("" ::: "memory");
        f32x4 gv[2][2];
        if (FINAL) {
#pragma unroll
            for (int bj = 0; bj < 2; ++bj)
#pragma unroll
                for (int n = 0; n < 2; ++n) gv[bj][n] = *(const f32x4*)(fgain + col0 + bj * HALF + n * 16); }
#pragma unroll
        for (int ai = 0; ai < 2; ++ai)
#pragma unroll
            for (int m = 0; m < 4; ++m) { const int row = row0 + ai * HALF + m * 16; const size_t off = (size_t)row * 2048 + col0;
                const float r = rsqrtf(__hip_atomic_load(ssq + row, __ATOMIC_RELAXED, __HIP_MEMORY_SCOPE_AGENT) * (1.0f / 2048.0f) + 1e-6f);
#pragma unroll
                for (int bj = 0; bj < 2; ++bj)
#pragma unroll
                    for (int n = 0; n < 2; ++n) { const f32x4 xo = acc[ai][bj][m][n] * r;
                        if (FINAL) *(f32x4*)(X + off + bj * HALF + n * 16) = xo * gv[bj][n];
                        else { unsigned long long w = (unsigned long long)cvt_pk_bf16(xo[0], xo[1]) | ((unsigned long long)cvt_pk_bf16(xo[2], xo[3]) << 32); *(unsigned long long*)(XB + off + bj * HALF + n * 16) = w; } } }
    }
};
struct TailOrder {
    int c, first, nM;
    __device__ __forceinline__ bool next(int i, Unit& u) const { if (i > 0 || c < first) return false; const int idx = c - first; u.pm = idx % nM; u.pn = idx / nM; return true; }
    __device__ __forceinline__ void a_ready(const Unit&) const {}
    __device__ __forceinline__ void done(const Unit&) const {}
};
template <class Epi, class Sched, bool ALIGN_EPI = false, bool SP2 = false>
__device__ __forceinline__ void gemm_phase(PG8_LAS unsigned char* lds, const Gemm g, const Sched& S, const Epi& E) {
    int tid_ = threadIdx.x; asm volatile("" : "+v"(tid_));
    const int tid = tid_, wid = __builtin_amdgcn_readfirstlane(tid >> 6), lane = tid & 63, wr = wid >> 2, wc = wid & 3, fr = lane & 15, fq = lane >> 4;
    const int K = g.K, nt = K / BK;
    unsigned voffA[2], voffB[2];
#pragma unroll
    for (int i = 0; i < 2; ++i) { int R, C; stage_rc(tid * 16 + i * 8192, R, C); const int Rb = Epi::PERM ? ((R & ~31) + perm32(R & 31)) : R;
        voffA[i] = (unsigned)(R * K + C) * 2u; voffB[i] = (unsigned)(Rb * K + C) * 2u; }
    const size_t kstep = (size_t)(BK * 2);
    const size_t hstep = (size_t)HALF * K * 2;
    const size_t tstep = 2 * hstep;
    const unsigned ldsw = (unsigned)wid * 1024u;
    const int aoff = lds_byte(wr * 64 + fr, fq * 8), boff = lds_byte(wc * 32 + fr, fq * 8);
#define PG8_SA(b, h) (((b) * 2 + (h)) * HTB)
#define PG8_SB(b, h) ((4 + (b) * 2 + (h)) * HTB)
#define PG8_STAGE(bufoff, gbase, voff) do { _Pragma("unroll") for (int _i = 0; _i < 2; ++_i) \
        __builtin_amdgcn_global_load_lds((const unsigned*)((const char*)(gbase) + (voff)[_i]), (PG8_LAS unsigned*)(lds + (bufoff) + ldsw + _i * 8192), 16, 0, 0); } while (0)
#define PG8_LDA(dst, b, h) do { _Pragma("unroll") for (int m = 0; m < 4; ++m) _Pragma("unroll") for (int k = 0; k < 2; ++k) dst[m][k] = *(const PG8_LAS bf16x8*)(lds + PG8_SA(b, h) + aoff + m * 2048 + k * 1024); } while (0)
#define PG8_LDB(dst, b, h) do { _Pragma("unroll") for (int n = 0; n < 2; ++n) _Pragma("unroll") for (int k = 0; k < 2; ++k) dst[n][k] = *(const PG8_LAS bf16x8*)(lds + PG8_SB(b, h) + boff + n * 2048 + k * 1024); } while (0)
#define PG8_MMA(ai, bj, At, Bt) do { __builtin_amdgcn_s_setprio(1); _Pragma("unroll") for (int m = 0; m < 4; ++m) _Pragma("unroll") for (int n = 0; n < 2; ++n) _Pragma("unroll") for (int k = 0; k < 2; ++k) \
        acc[ai][bj][m][n] = __builtin_amdgcn_mfma_f32_16x16x32_bf16(Bt[n][k], At[m][k], acc[ai][bj][m][n], 0, 0, 0); __builtin_amdgcn_s_setprio(0); } while (0)
#define PG8_WAIT_V(n) asm volatile("s_waitcnt vmcnt(" #n ")" ::: "memory")
#define PG8_WAIT_L(n) asm volatile("s_waitcnt lgkmcnt(" #n ")" ::: "memory")
#define PG8_BAR __builtin_amdgcn_s_barrier()
#define PG8_SCHED __builtin_amdgcn_sched_barrier(0)
    Unit cur, nxt; int ui = 0;
    if (!S.next(0, cur)) return;
    f32x4 acc[2][2][4][2];
#pragma unroll
    for (int a = 0; a < 2; ++a)
#pragma unroll
        for (int b = 0; b < 2; ++b)
#pragma unroll
            for (int m = 0; m < 4; ++m)
#pragma unroll
                for (int n = 0; n < 2; ++n) acc[a][b][m][n] = (f32x4){0.f, 0.f, 0.f, 0.f};
    bf16x8 At[4][2], B0[2][2], B1[2][2];
    const char* cA = (const char*)g.A + (size_t)cur.pm * tstep; const char* cB = (const char*)g.Bt + (size_t)cur.pn * tstep;
    S.a_ready(cur);
    if constexpr (SP2) {
        PG8_STAGE(PG8_SB(0, 0), cB, voffB); PG8_STAGE(PG8_SB(0, 1), cB + hstep, voffB); PG8_STAGE(PG8_SA(0, 0), cA, voffA); PG8_STAGE(PG8_SA(0, 1), cA + hstep, voffA);
        if (wr == 1) PG8_BAR;
        PG8_WAIT_V(2); PG8_BAR;
        PG8_STAGE(PG8_SB(1, 0), cB + kstep, voffB); PG8_STAGE(PG8_SA(1, 0), cA + kstep, voffA); PG8_STAGE(PG8_SB(1, 1), cB + hstep + kstep, voffB);
        PG8_WAIT_V(6); PG8_BAR;
    } else {
        PG8_STAGE(PG8_SB(0, 0), cB, voffB); PG8_STAGE(PG8_SA(0, 0), cA, voffA); PG8_STAGE(PG8_SB(0, 1), cB + hstep, voffB); PG8_STAGE(PG8_SA(0, 1), cA + hstep, voffA);
        if (wr == 1) PG8_BAR;
        PG8_WAIT_V(4); PG8_BAR;
        PG8_STAGE(PG8_SB(1, 0), cB + kstep, voffB); PG8_STAGE(PG8_SA(1, 0), cA + kstep, voffA); PG8_STAGE(PG8_SB(1, 1), cB + hstep + kstep, voffB);
        PG8_WAIT_V(6); PG8_BAR;
    }
    for (;;) {
        const bool has_next = S.next(ui + 1, nxt);
        const char* nA = has_next ? (const char*)g.A + (size_t)nxt.pm * tstep : cA; const char* nB = has_next ? (const char*)g.Bt + (size_t)nxt.pn * tstep : cB;
        for (int t = 0; t < nt; t += 2) {
            if constexpr (Epi::HAS_MID) { if (t == Epi::MID0 || t == Epi::MID1) E.mid(acc, cur, wr, wc, fr, fq, t == Epi::MID0 ? 0 : 1); }
            const bool last = (t == nt - 2);
            const char* a1 = cA + (size_t)(t + 1) * kstep;
            const char* a2 = last ? nA : cA + (size_t)(t + 2) * kstep; const char* b2 = last ? nB : cB + (size_t)(t + 2) * kstep;
            const char* a3 = a2 + kstep; const char* b3 = b2 + kstep;
            if (last && has_next) S.a_ready(nxt);
            if constexpr (SP2) {
            PG8_LDB(B0, 0, 0); PG8_LDB(B1, 0, 1); PG8_SCHED; PG8_LDA(At, 0, 0); PG8_STAGE(PG8_SA(1, 1), a1 + hstep, voffA);
            PG8_WAIT_V(8); PG8_WAIT_L(0); PG8_BAR; PG8_MMA(0, 0, At, B0); PG8_MMA(0, 1, At, B1); PG8_BAR; PG8_SCHED;
            PG8_LDA(At, 0, 1); PG8_STAGE(PG8_SB(0, 0), b2, voffB); PG8_STAGE(PG8_SB(0, 1), b2 + hstep, voffB); PG8_STAGE(PG8_SA(0, 0), a2, voffA);
            PG8_WAIT_V(8); PG8_WAIT_L(0); PG8_BAR; PG8_MMA(1, 0, At, B0); PG8_MMA(1, 1, At, B1); PG8_BAR; PG8_SCHED;
            PG8_LDB(B0, 1, 0); PG8_LDB(B1, 1, 1); PG8_SCHED; PG8_LDA(At, 1, 0); PG8_STAGE(PG8_SA(0, 1), a2 + hstep, voffA);
            PG8_WAIT_V(8); PG8_WAIT_L(0); PG8_BAR; PG8_MMA(0, 0, At, B0); PG8_MMA(0, 1, At, B1); PG8_BAR; PG8_SCHED;
            PG8_LDA(At, 1, 1); PG8_STAGE(PG8_SB(1, 0), b3, voffB); PG8_STAGE(PG8_SB(1, 1), b3 + hstep, voffB); PG8_STAGE(PG8_SA(1, 0), a3, voffA);
            PG8_WAIT_V(8); PG8_WAIT_L(0); PG8_BAR; PG8_MMA(1, 0, At, B0); PG8_MMA(1, 1, At, B1); PG8_BAR; PG8_SCHED;
            } else {
            PG8_LDB(B0, 0, 0); PG8_SCHED; PG8_LDA(At, 0, 0); PG8_STAGE(PG8_SA(1, 1), a1 + hstep, voffA);
            PG8_WAIT_L(8); PG8_BAR; PG8_WAIT_L(0); PG8_MMA(0, 0, At, B0); PG8_BAR; PG8_SCHED;
            PG8_LDB(B1, 0, 1); PG8_STAGE(PG8_SB(0, 0), b2, voffB);
            PG8_BAR; PG8_WAIT_L(0); PG8_MMA(0, 1, At, B1); PG8_BAR;
            PG8_LDA(At, 0, 1); PG8_STAGE(PG8_SA(0, 0), a2, voffA);
            PG8_BAR; PG8_WAIT_L(0); PG8_MMA(1, 0, At, B0); PG8_BAR; PG8_SCHED;
            PG8_STAGE(PG8_SB(0, 1), b2 + hstep, voffB);
            PG8_WAIT_V(6); PG8_BAR; PG8_MMA(1, 1, At, B1); PG8_BAR;
            PG8_LDB(B0, 1, 0); PG8_SCHED; PG8_LDA(At, 1, 0); PG8_STAGE(PG8_SA(0, 1), a2 + hstep, voffA);
            PG8_WAIT_L(8); PG8_BAR; PG8_WAIT_L(0); PG8_MMA(0, 0, At, B0); PG8_BAR; PG8_SCHED;
            PG8_LDB(B1, 1, 1); PG8_STAGE(PG8_SB(1, 0), b3, voffB);
            PG8_BAR; PG8_WAIT_L(0); PG8_MMA(0, 1, At, B1); PG8_BAR;
            PG8_LDA(At, 1, 1); PG8_STAGE(PG8_SA(1, 0), a3, voffA);
            PG8_BAR; PG8_WAIT_L(0); PG8_MMA(1, 0, At, B0); PG8_BAR; PG8_SCHED;
            PG8_STAGE(PG8_SB(1, 1), b3 + hstep, voffB);
            PG8_WAIT_V(6); PG8_BAR; PG8_MMA(1, 1, At, B1); PG8_BAR;
            }
        }
        if constexpr (ALIGN_EPI) { if (wr == 0) PG8_BAR; }
        if constexpr (!Epi::AFTER_DRAIN) { E(acc, cur, wr, wc, fr, fq); S.done(cur); }
        if (!has_next) break;
#pragma unroll
        for (int a = 0; a < 2; ++a)
#pragma unroll
            for (int b = 0; b < 2; ++b)
#pragma unroll
                for (int m = 0; m < 4; ++m)
#pragma unroll
                    for (int n = 0; n < 2; ++n) acc[a][b][m][n] = (f32x4){0.f, 0.f, 0.f, 0.f};
        cur = nxt; cA = nA; cB = nB; ++ui;
        if constexpr (ALIGN_EPI) { if (wr == 1) PG8_BAR; }
    }
    PG8_WAIT_V(0);
    if constexpr (!ALIGN_EPI) { if (wr == 0) PG8_BAR; }
    PG8_BAR;
    if constexpr (Epi::AFTER_DRAIN) { E.fused(acc, cur, wr, wc, fr, fq, lds, wid, lane); S.done(cur); }
#undef PG8_SA
#undef PG8_SB
#undef PG8_STAGE
#undef PG8_LDA
#undef PG8_LDB
#undef PG8_MMA
#undef PG8_WAIT_V
#undef PG8_WAIT_L
#undef PG8_BAR
#undef PG8_SCHED
}
}
#include <hip/hip_bf16.h>
#include <cmath>
namespace attn_body {
using bf16=__hip_bfloat16;
using bf16x8=__attribute__((ext_vector_type(8)))short;
using s16x4=__attribute__((ext_vector_type(4)))short;
using f32x16=__attribute__((ext_vector_type(16)))float;
using u32x4=__attribute__((ext_vector_type(4)))unsigned;
constexpr int BATCH=4,NHEAD=8,SEQ=4096,D=64,DM=12288,OPITCH=2048;
constexpr int NW=8,QBLK=32,QB=QBLK*NW,KVBLK=64,NQB=SEQ/QB;
constexpr int ATTN_PITCH=DM, ATTN_UNIT_ROWS=QB;
__device__ __forceinline__ int crow(int r,int hi){return (r&3)+8*(r>>2)+4*hi;}
#define SBAR() __builtin_amdgcn_sched_barrier(0)
__device__ __forceinline__ void cmask(f32x16&p0,f32x16&p1,int jb,int qrel,int hi){
  const float NEG=-INFINITY; int kb=64*jb+4*hi;
  #pragma unroll
  for(int r=0;r<16;++r){int kv=kb+(r&3)+8*(r>>2); if(kv>qrel)p0[r]=NEG; if(kv+32>qrel)p1[r]=NEG;}
}

constexpr int NSLOT=3, SLOTB=8192;
constexpr int LDS_K=0, LDS_V=NSLOT*SLOTB, LDS_WS=2*NSLOT*SLOTB, LDS_OST=LDS_WS+NW*64*4, LDS_BYTES=LDS_OST+NW*4096;
constexpr float C2=0.125f*1.4426950408889634f;
__device__ __forceinline__ void glds16(const void*gsrc,unsigned lds_dst){unsigned keep;
  asm volatile("s_mov_b32 %0, m0\n\ts_mov_b32 m0, %2\n\ts_nop 0\n\tglobal_load_lds_dwordx4 %1, off\n\ts_mov_b32 m0, %0":"=&s"(keep):"v"(gsrc),"s"(lds_dst):"memory");}
__device__ __forceinline__ float max3f(float a,float b,float c){float r;asm("v_max3_f32 %0, %1, %2, %3":"=v"(r):"v"(a),"v"(b),"v"(c));return r;}
__device__ __forceinline__ float max2f(float a,float b){float r;asm("v_max_f32_e32 %0, %1, %2":"=v"(r):"v"(a),"v"(b));return r;}
__device__ __forceinline__ float fadd_s(float a,float b){float r;asm("v_add_f32_e32 %0, %1, %2":"=v"(r):"v"(a),"v"(b));return r;}
__device__ __forceinline__ float fsub_s(float a,float b){float r;asm("v_sub_f32_e32 %0, %1, %2":"=v"(r):"v"(a),"v"(b));return r;}
typedef float f32x2_t __attribute__((ext_vector_type(2))); typedef __bf16 bf16x2_t __attribute__((ext_vector_type(2)));
__device__ __forceinline__ unsigned cvtpk_s(float lo,float hi){f32x2_t v={lo,hi};bf16x2_t b=__builtin_convertvector(v,bf16x2_t);return __builtin_bit_cast(unsigned,b);}
#define WAIT_BAR(N) asm volatile("s_waitcnt vmcnt(" #N ") lgkmcnt(0)\n\ts_barrier":::"memory")
typedef float f32x4_t __attribute__((ext_vector_type(4)));
typedef const __attribute__((address_space(3))) f32x4_t* lds_f4p;
#define CBIAS(P0,P1,t) do{ lds_f4p cp_=cb4+16*(t)+hi; _Pragma("unroll") for(int g_=0;g_<4;++g_){ const f32x4_t b0_=cp_[2*g_], b1_=cp_[2*g_+8]; P0[4*g_]+=b0_[0];P0[4*g_+1]+=b0_[1];P0[4*g_+2]+=b0_[2];P0[4*g_+3]+=b0_[3]; P1[4*g_]+=b1_[0];P1[4*g_+1]+=b1_[1];P1[4*g_+2]+=b1_[2];P1[4*g_+3]+=b1_[3]; } }while(0)

__device__ __forceinline__ void qkt(f32x16&p0,f32x16&p1,const char*Kslot,const bf16x8*qr,const f32x16&negm,int r32,int hi){
  const char*kb=Kslot+hi*1024+r32*16;
  #pragma unroll
  for(int d0=0;d0<4;++d0){
    const bf16x8 b0=*reinterpret_cast<const bf16x8*>(kb+d0*2048);
    const bf16x8 b1=*reinterpret_cast<const bf16x8*>(kb+d0*2048+512);
    if(d0==0){p0=__builtin_amdgcn_mfma_f32_32x32x16_bf16(b0,qr[0],negm,0,0,0);p1=__builtin_amdgcn_mfma_f32_32x32x16_bf16(b1,qr[0],negm,0,0,0);}
    else{p0=__builtin_amdgcn_mfma_f32_32x32x16_bf16(b0,qr[d0],p0,0,0,0);p1=__builtin_amdgcn_mfma_f32_32x32x16_bf16(b1,qr[d0],p1,0,0,0);}}
}
typedef __attribute__((address_space(3))) const char* lds_cptr;
typedef short v4i16_t __attribute__((ext_vector_type(4)));
__device__ __forceinline__ void kload8(bf16x8*kf,lds_cptr kp){
  kf[0]=*(const __attribute__((address_space(3))) bf16x8*)(kp);      kf[1]=*(const __attribute__((address_space(3))) bf16x8*)(kp+512);
  kf[2]=*(const __attribute__((address_space(3))) bf16x8*)(kp+2048); kf[3]=*(const __attribute__((address_space(3))) bf16x8*)(kp+2560);
  kf[4]=*(const __attribute__((address_space(3))) bf16x8*)(kp+4096); kf[5]=*(const __attribute__((address_space(3))) bf16x8*)(kp+4608);
  kf[6]=*(const __attribute__((address_space(3))) bf16x8*)(kp+6144); kf[7]=*(const __attribute__((address_space(3))) bf16x8*)(kp+6656);
}
__device__ __forceinline__ void kload2(bf16x8*kf,lds_cptr kp,int j){ kf[2*j]=*(const __attribute__((address_space(3))) bf16x8*)(kp+j*2048); kf[2*j+1]=*(const __attribute__((address_space(3))) bf16x8*)(kp+j*2048+512); }
__device__ __forceinline__ s16x4 vtr(lds_cptr p){ return __builtin_bit_cast(s16x4,__builtin_amdgcn_ds_read_tr16_b64_v4i16((__attribute__((address_space(3))) v4i16_t*)p)); }
__device__ __forceinline__ float rowmax(const f32x16&p0,const f32x16&p1){
  float a=max3f(p0[0],p0[1],p1[0]),b=max3f(p0[2],p0[3],p1[1]);a=max3f(a,p1[2],p1[3]);
  #pragma unroll
  for(int r=4;r<16;r+=4){a=max3f(a,p0[r],p0[r+1]);b=max3f(b,p0[r+2],p0[r+3]);a=max3f(a,p1[r],p1[r+1]);b=max3f(b,p1[r+2],p1[r+3]);}
  const float m=max2f(a,b);
  auto rr=__builtin_amdgcn_permlane32_swap(__float_as_uint(m),__float_as_uint(m),false,false);
  return max2f(__uint_as_float(rr[0]),__uint_as_float(rr[1]));
}
__device__ __forceinline__ void pv(f32x16*o,int vb,bf16x8 pa0,bf16x8 pa1,bf16x8 pa2,bf16x8 pa3){
  #pragma unroll
  for(int d0=0;d0<2;++d0){s16x4 lo[4],hi[4];
    #pragma unroll
    for(int ks=0;ks<4;++ks){
      asm volatile("ds_read_b64_tr_b16 %0,%1 offset:%c2":"=&v"(lo[ks]):"v"(vb),"i"(d0*4096+ks*1024):"memory");
      asm volatile("ds_read_b64_tr_b16 %0,%1 offset:%c2":"=&v"(hi[ks]):"v"(vb),"i"(d0*4096+ks*1024+512):"memory");}
    asm volatile("s_waitcnt lgkmcnt(0)":::"memory");SBAR();
    #define PK(k) (bf16x8){lo[k][0],lo[k][1],lo[k][2],lo[k][3],hi[k][0],hi[k][1],hi[k][2],hi[k][3]}
    o[d0]=__builtin_amdgcn_mfma_f32_32x32x16_bf16(pa0,PK(0),o[d0],0,0,0);
    o[d0]=__builtin_amdgcn_mfma_f32_32x32x16_bf16(pa1,PK(1),o[d0],0,0,0);
    o[d0]=__builtin_amdgcn_mfma_f32_32x32x16_bf16(pa2,PK(2),o[d0],0,0,0);
    o[d0]=__builtin_amdgcn_mfma_f32_32x32x16_bf16(pa3,PK(3),o[d0],0,0,0);
    #undef PK
  }
}

#ifndef ATTN_STORE16
#define ATTN_STORE16(p,v) (*(u32x4*)(p)=(v))
#endif
template<int THRL> __device__ __forceinline__ void attn_unit(int b,int h,int qb,const bf16*Q,const bf16*__restrict__ K,const bf16*__restrict__ V,bf16*O,const bf16*__restrict__ G,lds_f4p cb4_in,int T0,char*shm){
  int tid_=threadIdx.x; asm volatile("":"+v"(tid_)); const int tid=tid_,lane=tid&63,r32=lane&31,hi=lane>>5; const int wid=__builtin_amdgcn_readfirstlane(tid>>6);
  const long rowbase=(long)b*SEQ; const int q0=qb*QB; const lds_f4p cb4=cb4_in+16*T0; const __attribute__((address_space(3))) float* cbs=(const __attribute__((address_space(3))) float*)cb4;
  const bf16*Qw=Q+(rowbase+q0+wid*QBLK)*DM+h*D;
  const bf16*Kh=K+(rowbase+(long)T0*KVBLK)*DM+h*D,*Vh=V+(rowbase+(long)T0*KVBLK)*DM+h*D;
  const unsigned lds0=(unsigned)(uintptr_t)shm;
  float*wsf=(float*)(shm+LDS_WS)+wid*64;
  const bf16*ksrc=Kh+(long)lane*DM+wid*8;
  const bf16*vsrc=Vh+(long)(16*(wid&3)+(lane>>2))*DM+(wid>>2)*32+(lane&3)*8;
  const unsigned kdst=lds0+LDS_K+wid*1024, vdst=lds0+LDS_V+wid*1024;
  #define DMA_K(t,slot) glds16(ksrc+(long)(t)*KVBLK*DM,(unsigned)__builtin_amdgcn_readfirstlane(kdst+(slot)))
  #define DMA_V(t,slot) glds16(vsrc+(long)(t)*KVBLK*DM,(unsigned)__builtin_amdgcn_readfirstlane(vdst+(slot)))
  const int vb0=(int)(lds0+LDS_V)+((lane>>4)&1)*32+(lane&3)*8+(4*hi+((lane&15)>>2))*64;
  const char*Kbase=shm+LDS_K; bf16x8 kf[8];
  const lds_cptr shm3=(lds_cptr)shm; const lds_cptr kp0=shm3+LDS_K+hi*1024+r32*16; const lds_cptr vp0=shm3+LDS_V+((lane>>4)&1)*32+(lane&3)*8+(4*hi+((lane&15)>>2))*64;
  const int NT=(q0+QB)/KVBLK-T0;
  DMA_K(0,0);DMA_V(0,0);DMA_K(1,SLOTB);
  bf16x8 qr[4];
  #pragma unroll
  for(int d0=0;d0<4;++d0)qr[d0]=*reinterpret_cast<const bf16x8*>(&Qw[(long)r32*DM+d0*16+hi*8]);
  float mhat=0.f,l_reg=0.f;f32x16 o[2];o[0]=f32x16{};o[1]=f32x16{};f32x16 negm=f32x16{};asm volatile("":"+v"(negm));
  const int qrel=wid*QBLK+r32;
  #define CMASK(P0,P1,t) do{int jb_=(t)-(NT-4); if(jb_>=0)cmask(P0,P1,jb_,qrel,hi);}while(0)
  bool resc=false;
  #define START(P0,P1) do{ const float rm=rowmax(P0,P1); resc=false; \
    { const float dl=rm; mhat=fadd_s(mhat,dl); \
      _Pragma("unroll") for(int r=0;r<16;++r){P0[r]=fsub_s(P0[r],dl);P1[r]=fsub_s(P1[r],dl);} \
      _Pragma("unroll") for(int r=0;r<16;++r)negm[r]=-mhat; asm volatile("":"+v"(negm)); } \
    _Pragma("unroll") for(int r=0;r<16;++r)P0[r]=__builtin_amdgcn_exp2f(P0[r]); }while(0)
  #define RESC() do{ if(resc){ asm volatile("s_waitcnt lgkmcnt(0)":::"memory"); \
      _Pragma("unroll") for(int d_=0;d_<2;++d_) _Pragma("unroll") for(int r=0;r<16;++r)o[d_][r]*=wsf[crow(r,hi)]; } }while(0)
  f32x16 pA0,pA1,pB0,pB1;
  int sl_prev=0,sl_cur=0,sl_next=SLOTB;
  #define ROT() do{sl_prev=sl_cur;sl_cur=sl_next;sl_next=(sl_next==(NSLOT-1)*SLOTB)?0:sl_next+SLOTB;}while(0)
  DMA_K(2,2*SLOTB);
  WAIT_BAR(3);
  qkt(pA0,pA1,Kbase,qr,negm,r32,hi);asm volatile("s_nop 15\n\ts_nop 7":"+v"(pA0),"+v"(pA1));CBIAS(pA0,pA1,0);CMASK(pA0,pA1,0);
  START(pA0,pA1);
  _Pragma("unroll") for(int r=0;r<16;++r)pA1[r]=__builtin_amdgcn_exp2f(pA1[r]);
  WAIT_BAR(0);
  DMA_K(3,0);DMA_V(1,SLOTB);
  ROT();
  kload8(kf,kp0+sl_cur);
  WAIT_BAR(2);
  s16x4 vlo[8],vhi[8]; u32x4 pw0,pw1,pw2,pw3;
  #define PKW(P,B) cvtpk_s(P[B],P[B+1])
  #define PAF(k) __builtin_bit_cast(bf16x8,pw##k)
  #define VFR(i) (bf16x8){vlo[i][0],vlo[i][1],vlo[i][2],vlo[i][3],vhi[i][0],vhi[i][1],vhi[i][2],vhi[i][3]}
  #define PIN(x) asm volatile("":"+v"(x))
  #define MX3(a,b,c) __builtin_fmaxf(__builtin_fmaxf((a),(b)),(c))
  #define GAPA(MF,A0,A1,A2,A3,W0,W1,PW) do{ MF; sacc+=A0; sacc+=A1; sacc+=A2; sacc+=A3; PIN(sacc); W0; W1; PIN(PW); SBAR(); }while(0)
  #define EX(v) __builtin_amdgcn_exp2f(v)
  #define GAPB(MF,X,B,NI) do{ const f32x4_t bc_=bnx_; bnx_=cp_[NI]; MF; X[B]=EX(X[B]+bc_[0]); X[B+1]=EX(X[B+1]+bc_[1]); X[B+2]=EX(X[B+2]+bc_[2]); X[B+3]=EX(X[B+3]+bc_[3]); PIN(X); SBAR(); }while(0)
  #define VRD(i) do{ vlo[i]=vtr(vp_+(((i)>>2)*4096+((i)&3)*1024)); vhi[i]=vtr(vp_+(((i)>>2)*4096+((i)&3)*1024+512)); }while(0)
  #define KRD(G,j) do{ if(G){ kload2(kf,kp0+sl_next,j); SBAR(); } }while(0)
  #define STEP(C0,C1,P0,P1,t,GK,GV,GL) do{ SBAR(); \
    const lds_cptr vp_=vp0+sl_prev; \
    VRD(0); SBAR(); float sacc=(P0[0]+P0[1]); \
    GAPA(C0=__builtin_amdgcn_mfma_f32_32x32x16_bf16(kf[0],qr[0],negm,0,0,0), P0[2],P0[3],P0[4],P0[5],     pw0[0]=PKW(P0,0), pw0[1]=PKW(P0,2), pw0); \
    VRD(4); SBAR(); GAPA(C1=__builtin_amdgcn_mfma_f32_32x32x16_bf16(kf[1],qr[0],negm,0,0,0), P0[6],P0[7],P0[8],P0[9],     pw0[2]=PKW(P0,4), pw0[3]=PKW(P0,6), pw0); \
    VRD(1); SBAR(); GAPA(C0=__builtin_amdgcn_mfma_f32_32x32x16_bf16(kf[2],qr[1],C0,0,0,0),   P0[10],P0[11],P0[12],P0[13], pw1[0]=PKW(P0,8), pw1[1]=PKW(P0,10), pw1); \
    VRD(5); SBAR(); GAPA(C1=__builtin_amdgcn_mfma_f32_32x32x16_bf16(kf[3],qr[1],C1,0,0,0),   P0[14],P0[15],P1[0],P1[1],   pw1[2]=PKW(P0,12),pw1[3]=PKW(P0,14), pw1); \
    VRD(2); SBAR(); GAPA(C0=__builtin_amdgcn_mfma_f32_32x32x16_bf16(kf[4],qr[2],C0,0,0,0),   P1[2],P1[3],P1[4],P1[5],     pw2[0]=PKW(P1,0), pw2[1]=PKW(P1,2), pw2); \
    VRD(6); SBAR(); GAPA(C1=__builtin_amdgcn_mfma_f32_32x32x16_bf16(kf[5],qr[2],C1,0,0,0),   P1[6],P1[7],P1[8],P1[9],     pw2[2]=PKW(P1,4), pw2[3]=PKW(P1,6), pw2); \
    VRD(3); SBAR(); GAPA(C0=__builtin_amdgcn_mfma_f32_32x32x16_bf16(kf[6],qr[3],C0,0,0,0),   P1[10],P1[11],P1[12],P1[13], pw3[0]=PKW(P1,8), pw3[1]=PKW(P1,10), pw3); \
    VRD(7); SBAR(); GAPA(C1=__builtin_amdgcn_mfma_f32_32x32x16_bf16(kf[7],qr[3],C1,0,0,0),   P1[14],P1[15],0.f,0.f,       pw3[2]=PKW(P1,12),pw3[3]=PKW(P1,14), pw3); \
    l_reg+=sacc; \
    if(GK){DMA_K((t)+3,sl_cur);} if(GV){DMA_V((t)+1,sl_next);} \
    CMASK(C0,C1,t); \
    { float a=MX3(C0[0],C0[1],C1[0]),b=MX3(C0[2],C0[3],C1[1]); a=MX3(a,C1[2],C1[3]); \
      _Pragma("unroll") for(int r=4;r<16;r+=4){a=MX3(a,C0[r],C0[r+1]);b=MX3(b,C0[r+2],C0[r+3]);a=MX3(a,C1[r],C1[r+1]);b=MX3(b,C1[r+2],C1[r+3]);} \
      float rm=__builtin_fmaxf(a,b); { auto rr=__builtin_amdgcn_permlane32_swap(__float_as_uint(rm),__float_as_uint(rm),false,false); rm=__builtin_fmaxf(__uint_as_float(rr[0]),__uint_as_float(rr[1])); } \
      rm+=cbs[64*(t)+63]; resc=false; \
      if(__builtin_expect(__any(rm>(float)THRL),0)){ const float dl=__builtin_fmaxf(rm,0.f); mhat+=dl; \
        _Pragma("unroll") for(int r=0;r<16;++r){C0[r]-=dl;C1[r]-=dl;} \
        _Pragma("unroll") for(int r=0;r<16;++r)negm[r]=-mhat; asm volatile("":"+v"(negm)); \
        const float f=__builtin_amdgcn_exp2f(-dl); l_reg*=f; if(hi==0)wsf[r32]=f; resc=true; } } \
    lds_f4p cp_=cb4+16*(t)+hi; f32x4_t bnx_=cp_[0]; SBAR(); \
    GAPB(o[0]=__builtin_amdgcn_mfma_f32_32x32x16_bf16(PAF(0),VFR(0),o[0],0,0,0), C0,0,2); \
    GAPB(o[1]=__builtin_amdgcn_mfma_f32_32x32x16_bf16(PAF(0),VFR(4),o[1],0,0,0), C0,4,4); \
    KRD(GL,0); GAPB(o[0]=__builtin_amdgcn_mfma_f32_32x32x16_bf16(PAF(1),VFR(1),o[0],0,0,0), C0,8,6); \
    KRD(GL,1); GAPB(o[1]=__builtin_amdgcn_mfma_f32_32x32x16_bf16(PAF(1),VFR(5),o[1],0,0,0), C0,12,8); \
    KRD(GL,2); GAPB(o[0]=__builtin_amdgcn_mfma_f32_32x32x16_bf16(PAF(2),VFR(2),o[0],0,0,0), C1,0,10); \
    KRD(GL,3); GAPB(o[1]=__builtin_amdgcn_mfma_f32_32x32x16_bf16(PAF(2),VFR(6),o[1],0,0,0), C1,4,12); \
    GAPB(o[0]=__builtin_amdgcn_mfma_f32_32x32x16_bf16(PAF(3),VFR(3),o[0],0,0,0), C1,8,14); \
    GAPB(o[1]=__builtin_amdgcn_mfma_f32_32x32x16_bf16(PAF(3),VFR(7),o[1],0,0,0), C1,12,14); \
    }while(0)
  int t=1;
  #undef CMASK
  #define CMASK(P0,P1,t) do{}while(0)
  for(;t+5<NT;t+=2){
    STEP(pB0,pB1,pA0,pA1,t,true,true,true);     WAIT_BAR(2); RESC(); ROT();
    STEP(pA0,pA1,pB0,pB1,t+1,true,true,true);   WAIT_BAR(2); RESC(); ROT();
  }
  #undef CMASK
  #define CMASK(P0,P1,t) do{int jb_=(t)-(NT-4); if(jb_>=0)cmask(P0,P1,jb_,qrel,hi);}while(0)
  #define ENDW(tt) do{ if((tt)+3<NT){WAIT_BAR(2);} else if((tt)+2<NT){WAIT_BAR(1);} else {WAIT_BAR(0);} }while(0)
  for(;t+1<NT;t+=2){
    STEP(pB0,pB1,pA0,pA1,t,(t+3<NT),(t+1<NT),(t+1<NT));       ENDW(t);   RESC(); ROT();
    STEP(pA0,pA1,pB0,pB1,t+1,(t+4<NT),(t+2<NT),(t+2<NT));     ENDW(t+1); RESC(); ROT();
  }
  STEP(pB0,pB1,pA0,pA1,NT-1,false,false,false); RESC();
  { float sacc=pB0[0]+pB0[1]; _Pragma("unroll") for(int r=2;r<16;++r)sacc+=pB0[r]; _Pragma("unroll") for(int r=0;r<16;++r)sacc+=pB1[r]; l_reg+=sacc;
    pw0=(u32x4){PKW(pB0,0),PKW(pB0,2),PKW(pB0,4),PKW(pB0,6)};pw1=(u32x4){PKW(pB0,8),PKW(pB0,10),PKW(pB0,12),PKW(pB0,14)};pw2=(u32x4){PKW(pB1,0),PKW(pB1,2),PKW(pB1,4),PKW(pB1,6)};pw3=(u32x4){PKW(pB1,8),PKW(pB1,10),PKW(pB1,12),PKW(pB1,14)};
    SBAR(); pv(o,vb0+sl_cur,PAF(0),PAF(1),PAF(2),PAF(3)); }
  #undef PKW
  #undef PAF
  #undef VFR
  #undef PIN
  #undef MX3
  #undef GAPA
  #undef GAPB
  #undef EX
  #undef VRD
  #undef KRD
  #undef STEP
  #undef ENDW
  {auto rr=__builtin_amdgcn_permlane32_swap(__float_as_uint(l_reg),__float_as_uint(l_reg),false,false);l_reg=__uint_as_float(rr[0])+__uint_as_float(rr[1]);}
  if(hi==0)wsf[32+r32]=l_reg;asm volatile("s_waitcnt lgkmcnt(0)":::"memory");
  float rli[16];
  #pragma unroll
  for(int r=0;r<16;++r)rli[r]=__builtin_amdgcn_rcpf(wsf[32+crow(r,hi)]);
  bf16*Ow=O+(rowbase+q0+wid*QBLK)*OPITCH+h*D; const bf16*Gw=G+(rowbase+q0+wid*QBLK)*DM+h*D;
  { bf16*stg=(bf16*)(shm+LDS_OST)+wid*2048;
    #pragma unroll
    for(int r=0;r<16;++r){const int orow=crow(r,hi);
      #pragma unroll
      for(int d0=0;d0<2;++d0)stg[orow*64+d0*32+r32]=__float2bfloat16(o[d0][r]*rli[r]);}
    asm volatile("s_waitcnt lgkmcnt(0)":::"memory");
    #pragma unroll
    for(int i=0;i<4;++i){const int row=i*8+(lane>>3),ch=lane&7; u32x4 v=*(const u32x4*)(stg+row*64+ch*8); const u32x4 gg=*(const u32x4*)(Gw+(long)row*DM+ch*8);
      _Pragma("unroll") for(int e_=0;e_<4;++e_){ const float a0=__uint_as_float(v[e_]<<16)*__uint_as_float(gg[e_]<<16), a1=__uint_as_float(v[e_]&0xffff0000u)*__uint_as_float(gg[e_]&0xffff0000u); v[e_]=cvtpk_s(a0,a1); }
      ATTN_STORE16(Ow+(long)row*OPITCH+ch*8,v);} }
  asm volatile("s_waitcnt lgkmcnt(0)\n\ts_barrier":::"memory");
  #undef DMA_K
  #undef DMA_V
  #undef CMASK
  #undef START
  #undef RESC
  #undef ROT
}
constexpr int ATTN_LDS_BYTES=LDS_BYTES;
#undef SBAR
#undef WAIT_BAR
}
#define LAS __attribute__((address_space(3)))
typedef unsigned short bf16;
typedef unsigned v4u __attribute__((ext_vector_type(4)));
typedef unsigned v2u __attribute__((ext_vector_type(2)));
typedef float f32x4 __attribute__((ext_vector_type(4)));
typedef short bf16x8 __attribute__((ext_vector_type(8)));
typedef short s16x4 __attribute__((ext_vector_type(4)));
using pg8::bf_lo; using pg8::bf_hi;
constexpr int NWAVES = 8, NTHR = 512;
constexpr int BATCH = 4, SEQ = 4096, DM = 2048, T = BATCH * SEQ, DEPTH = 2, MEMLEN = 256, MROWS = BATCH * MEMLEN;
constexpr int INC = 12312, NZ = 12544, ZP = 12288;
constexpr int ZC_GQ = 0, ZC_GK = 512, ZC_GV = 1024, ZC_GG = 2048, ZC_FQ = 3072, ZC_FK = 3584, ZC_FV = 4096, ZC_FG = 4608, ZC_MQ = 5120, ZC_MG = 5632, ZC_MERGE = 6144;
constexpr size_t MiB = 1u << 20;
constexpr size_t WS_WIN = 0, WS_WBR = 98 * MiB, WS_WOUT = 114 * MiB, WS_WKV = 130 * MiB, WS_XB = 138 * MiB, WS_Y = 202 * MiB, WS_U = 266 * MiB, WS_Z = 330 * MiB,
                 WS_ZS = 714 * MiB, WS_MEMB = 716 * MiB, WS_MKV = 720 * MiB, WS_DV = 724 * MiB, WS_SS = 725 * MiB, WS_CTL = 726 * MiB, WS_FOXT = 727 * MiB, WS_END = 728 * MiB;
constexpr int FT_CBL = 0, FT_SEG = 32 * 4096, FT_QNB = FT_SEG + 32 * 8, FT_KNS = FT_QNB + 32 * 16;
constexpr size_t CTL_ZERO_BYTES = 65536;
constexpr int LDS_BYTES = 155648;

typedef float f32x2c_t __attribute__((ext_vector_type(2))); typedef __bf16 bf16x2c_t __attribute__((ext_vector_type(2)));
__device__ __forceinline__ unsigned pk2(float lo, float hi) { const f32x2c_t v = {lo, hi}; return __builtin_bit_cast(unsigned, __builtin_convertvector(v, bf16x2c_t)); }
__device__ __forceinline__ unsigned f2bf(float f) { return pk2(f, 0.f) & 0xffffu; }
__device__ __forceinline__ float bf2f(bf16 v) { return __uint_as_float(((unsigned)v) << 16); }
__device__ __forceinline__ float wave_sum(float v) {
#pragma unroll
    for (int o = 1; o < 64; o <<= 1) v += __shfl_xor(v, o);
    return v;
}
__device__ __forceinline__ float logsig(float x) { return fminf(x, 0.f) - __logf(1.f + __expf(-fabsf(x))); }
#define DPP_ADD(v, ctrl) ((v) + __builtin_bit_cast(float, __builtin_amdgcn_update_dpp(0, __builtin_bit_cast(int, (v)), (ctrl), 0xF, 0xF, true)))
__device__ __forceinline__ float row16_sum(float v) { v = DPP_ADD(v, 0xB1); v = DPP_ADD(v, 0x4E); v = DPP_ADD(v, 0x141); v = DPP_ADD(v, 0x140); return v; }
#define MFMA16(a, b, c) __builtin_amdgcn_mfma_f32_16x16x32_bf16((a), (b), (c), 0, 0, 0)
__device__ __forceinline__ s16x4 trread(const LAS unsigned char* p) { return __builtin_bit_cast(s16x4, __builtin_amdgcn_ds_read_tr16_b64_v4i16((LAS s16x4*)p)); }
__device__ __forceinline__ bf16x8 cat8(s16x4 lo, s16x4 hi) { return (bf16x8){lo[0], lo[1], lo[2], lo[3], hi[0], hi[1], hi[2], hi[3]}; }

#define GAS __attribute__((address_space(1)))
#define XB_TMO      128
#define XB_XCNT(j)  (256  + 64 * (j))
#define XB_XSUB(j)  (1280 + 64 * (j))
#define XB_XGEN(j)  (2304 + 64 * (j))
#define XB_TOP      3328
#define XB_TOPGEN   3392
#define XCD_BAR_WORDS 3456
#define XB_SPIN_CAP (1u << 18)

__device__ __forceinline__ unsigned xb_ld(unsigned* p)              { return __hip_atomic_load(p, __ATOMIC_RELAXED, __HIP_MEMORY_SCOPE_AGENT); }
__device__ __forceinline__ unsigned xb_add(unsigned* p, unsigned v) { return __hip_atomic_fetch_add(p, v, __ATOMIC_RELAXED, __HIP_MEMORY_SCOPE_AGENT); }
__device__ __forceinline__ unsigned xb_xcc_id() { return (unsigned)__builtin_amdgcn_s_getreg((3 << 11) | 20) & 0xFu; }
#define XB_SPIN(cond, bar) do { unsigned _sp = 0; while (cond) { __builtin_amdgcn_s_sleep(1); \
    if ((++_sp & 255u) == 0u) { if (xb_ld(&(bar)[XB_TMO])) break; if (_sp > XB_SPIN_CAP) { atomicAdd(&(bar)[XB_TMO], 1u); break; } } } } while (0)

struct XcdBarrier {
    unsigned* bar; unsigned x;
    volatile LAS unsigned* st;
};

__device__ __forceinline__ XcdBarrier xcd_barrier_post(unsigned* bar, volatile LAS unsigned* st) {
    XcdBarrier b; b.bar = bar; b.x = xb_xcc_id(); b.st = st;
    if (threadIdx.x == 0) (void)xb_add(&bar[XB_XCNT(b.x)], 1u);
    return b;
}
__device__ __forceinline__ void xcd_barrier_complete(unsigned* bar, unsigned x, unsigned& nloc, unsigned& nx) {
    const unsigned G = gridDim.x * gridDim.y * gridDim.z;
    unsigned sum, cnt, mine, sp = 0u;
    for (;;) {
        sum = 0u; cnt = 0u; mine = 0u;
#pragma unroll
        for (unsigned j = 0; j < 16; ++j) { const unsigned c = xb_ld(&bar[XB_XCNT(j)]); sum += c; cnt += (c > 0u) ? 1u : 0u; mine = (j == x) ? c : mine; }
        if (sum == G) break;
        __builtin_amdgcn_s_sleep(1);
        if ((++sp & 255u) == 0u) { if (xb_ld(&bar[XB_TMO])) break; if (sp > XB_SPIN_CAP) { atomicAdd(&bar[XB_TMO], 1u); break; } }
    }
    nloc = mine > 0u ? mine : 1u; nx = cnt > 0u ? cnt : 1u;
}

__device__ __forceinline__ void xcd_barrier(const XcdBarrier& b) {
    asm volatile("s_waitcnt vmcnt(0)" ::: "memory");
    __syncthreads();
    if (threadIdx.x == 0) {
        unsigned* bar = b.bar; asm volatile("" : "+s"(bar));
        const unsigned bx_ = xb_xcc_id();
        __builtin_amdgcn_s_waitcnt(0);
        unsigned nloc = b.st[0], nx = b.st[1];
        if (nloc == 0u) { xcd_barrier_complete(bar, bx_, nloc, nx); b.st[0] = nloc; b.st[1] = nx; }
        const unsigned old = xb_add(&bar[XB_XSUB(bx_)], 1u);
        const unsigned gen = old / nloc;
        if (old + 1u == (gen + 1u) * nloc) {
            __builtin_amdgcn_fence(__ATOMIC_RELEASE, "agent");
            asm volatile("s_waitcnt vmcnt(0)" ::: "memory");
            const unsigned og = xb_add(&bar[XB_TOP], 1u);
            const unsigned tg = og / nx;
            if (og + 1u == (tg + 1u) * nx) xb_add(&bar[XB_TOPGEN], 1u);
            else XB_SPIN(xb_ld(&bar[XB_TOPGEN]) == tg, bar);
            __builtin_amdgcn_fence(__ATOMIC_ACQUIRE, "agent");
            xb_add(&bar[XB_XGEN(bx_)], 1u);
            asm volatile("s_waitcnt vmcnt(0)" ::: "memory");
        } else {
            XB_SPIN(xb_ld(&bar[XB_XGEN(bx_)]) == gen, bar);
            __builtin_amdgcn_fence(__ATOMIC_ACQUIRE, "agent");
            asm volatile("s_waitcnt vmcnt(0)" ::: "memory");
        }
    }
    __syncthreads();
}


struct Params {
    const float *x, *mem, *norm_gain, *w_in, *w_gk_up, *b_gk, *gla_norm_gain, *b_f, *mem_norm_gain, *w_mem_kv, *w_branch, *w_out, *final_gain;
    float* out; unsigned char* ws;
};

__device__ __forceinline__ int win_src_col(int n) {
    if (n < 3072) return n;
    if (n < 4608) return n + 16;
    if (n < 12288) return n + 24;
    if (n < 12304) return 3072 + (n - 12288);
    if (n < 12312) return 4624 + (n - 12304);
    return -1;
}
__device__ __forceinline__ void transpose_item(const float* W, int Nsrc, const float* gain, int kind, bf16* WT, int item, int nblk, int lane) {
    const int kb = item / nblk, nb = item % nblk, k0 = 64 * kb, nn = 64 * nb + lane;
    const int sc = kind == 0 ? win_src_col(nn) : nn;
    const float* src = W + (size_t)k0 * Nsrc + (sc >= 0 ? sc : 0);
    float v[64];
#pragma unroll
    for (int kk = 0; kk < 64; ++kk) v[kk] = src[(size_t)kk * Nsrc];
    if (gain) {
#pragma unroll
        for (int q = 0; q < 16; ++q) { const f32x4 g = *(const f32x4*)(gain + k0 + 4 * q); v[4 * q] *= g[0]; v[4 * q + 1] *= g[1]; v[4 * q + 2] *= g[2]; v[4 * q + 3] *= g[3]; } }
    if (sc < 0) {
#pragma unroll
        for (int kk = 0; kk < 64; ++kk) v[kk] = 0.f; }
    bf16* dst = WT + (size_t)nn * 2048 + k0;
#pragma unroll
    for (int c = 0; c < 8; ++c) { v4u o; o.x = pk2(v[8 * c], v[8 * c + 1]); o.y = pk2(v[8 * c + 2], v[8 * c + 3]); o.z = pk2(v[8 * c + 4], v[8 * c + 5]); o.w = pk2(v[8 * c + 6], v[8 * c + 7]); *(v4u*)(dst + 8 * c) = o; }
}
__device__ __forceinline__ void row_to_bf16(const float* xrow, bf16* orow, int lane) {
    const f32x4* xr = (const f32x4*)xrow + lane; float s = 0.f; v2u* o8 = (v2u*)orow + lane; f32x4 v[8];
#pragma unroll
    for (int j = 0; j < 8; ++j) { v[j] = xr[64 * j]; s += (v[j].x * v[j].x + v[j].y * v[j].y) + (v[j].z * v[j].z + v[j].w * v[j].w); }
    const float r = rsqrtf(wave_sum(s) * (1.0f / 2048.0f) + 1e-6f);
#pragma unroll
    for (int j = 0; j < 8; ++j) { v2u w; w.x = pk2(v[j].x * r, v[j].y * r); w.y = pk2(v[j].z * r, v[j].w * r); o8[64 * j] = w; }
}
__device__ __forceinline__ void rescale_rows(bf16* xb, const float* ssq, int tid, int G) {
    const int lane = tid & 63, wave = tid >> 6;
    for (int m = blockIdx.x * NWAVES + wave; m < T; m += G * NWAVES) { const float r = rsqrtf(ssq[m] * (1.0f / 2048.0f) + 1e-6f); v2u* o8 = (v2u*)(xb + (size_t)m * DM) + lane;
#pragma unroll
        for (int j = 0; j < 8; ++j) { v2u w = o8[64 * j]; w.x = pk2(bf_lo(w.x) * r, bf_hi(w.x) * r); w.y = pk2(bf_lo(w.y) * r, bf_hi(w.y) * r); o8[64 * j] = w; } }
}
__device__ __forceinline__ void phase_prologue(const Params& P, LAS unsigned char* lds, int tid, int G) {
    const int lane = tid & 63, wave = tid >> 6; const int gw = blockIdx.x * NWAVES + wave, NGW = G * NWAVES;
    unsigned char* ws = P.ws;
    constexpr int I_IN = 32 * (NZ / 64), I_BR = 32 * 32, I_OUT = 32 * 32, I_KV = 32 * 16, I_L = I_IN + I_BR + I_OUT + I_KV;
    for (int it = gw; it < DEPTH * I_L; it += NGW) {
        const int l = it / I_L; int r = it % I_L;
        if (r < I_IN) { transpose_item(P.w_in + (size_t)l * 2048 * INC, INC, P.norm_gain + l * 2048, 0, (bf16*)(ws + WS_WIN) + (size_t)l * NZ * 2048, r, NZ / 64, lane); continue; } r -= I_IN;
        if (r < I_BR) { transpose_item(P.w_branch + (size_t)l * 2048 * 2048, 2048, nullptr, 1, (bf16*)(ws + WS_WBR) + (size_t)l * 2048 * 2048, r, 32, lane); continue; } r -= I_BR;
        if (r < I_OUT) { transpose_item(P.w_out + (size_t)l * 2048 * 2048, 2048, nullptr, 1, (bf16*)(ws + WS_WOUT) + (size_t)l * 2048 * 2048, r, 32, lane); continue; } r -= I_OUT;
        transpose_item(P.w_mem_kv + (size_t)l * 2048 * 1024, 1024, P.mem_norm_gain + l * 2048, 1, (bf16*)(ws + WS_WKV) + (size_t)l * 1024 * 2048, r, 16, lane);
    }
    float* ss = (float*)(ws + WS_SS);
    for (int m = gw; m < T; m += NGW) row_to_bf16(P.x + (size_t)m * DM, (bf16*)(ws + WS_XB) + (size_t)m * DM, lane);
    for (int m = gw; m < MROWS; m += NGW) row_to_bf16(P.mem + (size_t)m * DM, (bf16*)(ws + WS_MEMB) + (size_t)m * DM, lane);
    for (int i = blockIdx.x * NTHR + tid; i < 2 * T; i += G * NTHR) ss[T + i] = 0.f;
}
__device__ __forceinline__ void gla_decay(LAS float* gd, LAS float* tot, int tid, const float (&w)[16], float bias, float (&bv)[16], float& blast) {
    const int d = tid & 127, rg = tid >> 7;
    float run = 0.f;
#pragma unroll
    for (int c = 0; c < 16; ++c) { const LAS f32x4* g4 = (const LAS f32x4*)(gd + (rg * 16 + c) * 16); float a = bias;
#pragma unroll
        for (int q = 0; q < 4; ++q) { const f32x4 g = g4[q]; a += g[0] * w[4 * q] + g[1] * w[4 * q + 1] + g[2] * w[4 * q + 2] + g[3] * w[4 * q + 3]; }
        run += logsig(a) * 0.0625f; bv[c] = run; }
    tot[rg * 128 + d] = run;
    __syncthreads();
    const float t0 = tot[d], t1 = tot[128 + d], t2 = tot[256 + d], t3 = tot[384 + d];
    const float off = (rg > 0 ? t0 : 0.f) + (rg > 1 ? t1 : 0.f) + (rg > 2 ? t2 : 0.f);
    blast = (t0 + t1) + (t2 + t3);
#pragma unroll
    for (int c = 0; c < 16; ++c) bv[c] += off;
}
__device__ __forceinline__ void load_v(const bf16* src, int tid, v4u (&r)[4]) {
#pragma unroll
    for (int i = 0; i < 4; ++i) { const int idx = tid + 512 * i, row = idx >> 5, ch = idx & 31; r[i] = *(const v4u*)(src + (size_t)row * ZP + ch * 8); }
}
__device__ __forceinline__ void store_v(LAS unsigned char* vt, int tid, const v4u (&r)[4]) {
#pragma unroll
    for (int i = 0; i < 4; ++i) { const int idx = tid + 512 * i, row = idx >> 5, ch = idx & 31; *(LAS v4u*)(vt + row * 544 + ch * 16) = r[i]; }
}
struct G1Pre { v4u vr[4]; };
__device__ __forceinline__ void gla_step1_pre(const Params& P, int item, int tid, G1Pre& R) {
    const int bh = item >> 6, n = item & 63, b = bh >> 2, h = bh & 3; const int t0 = b * SEQ + n * 64; const bf16* z = (const bf16*)(P.ws + WS_Z);
    load_v(z + (size_t)t0 * ZP + ZC_GV + h * 256, tid, R.vr);
}
__device__ __forceinline__ void gla_step1(const Params& P, int l, LAS unsigned char* lds, int item, int next_item, int tid, G1Pre& R) {
    const int bh = item >> 6, n = item & 63, b = bh >> 2, h = bh & 3; const int t0 = b * SEQ + n * 64;
    const bf16* z = (const bf16*)(P.ws + WS_Z); const float* zs = (const float*)(P.ws + WS_ZS);
    LAS unsigned char* KD = lds; LAS unsigned char* VT = lds + 18432; LAS float* GD = (LAS float*)(lds + 53248); LAS float* TOT = (LAS float*)(lds + 57344);
    const int d = tid & 127, rg = tid >> 7;
    f32x4 gdr = (f32x4){0.f, 0.f, 0.f, 0.f}; if (tid < 256) gdr = *(const f32x4*)(zs + (size_t)t0 * 32 + (tid >> 2) * 32 + (tid & 3) * 4);
    float wv[16]; { const float* wup = P.w_gk_up + (size_t)l * 16 * 512 + h * 128;
#pragma unroll
      for (int r = 0; r < 16; ++r) wv[r] = wup[r * 512 + d]; }
    const float bias = P.b_gk[l * 512 + h * 128 + d];
    bf16 kraw[16];
#pragma unroll
    for (int c = 0; c < 16; ++c) kraw[c] = z[(size_t)(t0 + rg * 16 + c) * ZP + ZC_GK + h * 128 + d];
    __syncthreads();
    if (tid < 256) *(LAS f32x4*)(GD + (tid >> 2) * 16 + (tid & 3) * 4) = gdr;
    store_v(VT, tid, R.vr);
    __syncthreads();
    float bv[16], blast;
    gla_decay(GD, TOT, tid, wv, bias, bv, blast);
    { unsigned pk[8];
#pragma unroll
      for (int c = 0; c < 16; c += 2) { const float k0 = bf2f(kraw[c]) * __expf(blast - bv[c]), k1 = bf2f(kraw[c + 1]) * __expf(blast - bv[c + 1]); pk[c >> 1] = pk2(k0, k1); }
      *(LAS v4u*)(KD + d * 144 + rg * 32) = (v4u){pk[0], pk[1], pk[2], pk[3]}; *(LAS v4u*)(KD + d * 144 + rg * 32 + 16) = (v4u){pk[4], pk[5], pk[6], pk[7]}; }
    if (rg == 0) ((float*)(P.ws + WS_DV))[(size_t)item * 128 + d] = __expf(blast);
    if (next_item >= 0) gla_step1_pre(P, next_item, tid, R);
    __syncthreads();
    const int lane = tid & 63, w = tid >> 6, i = lane & 15, quad = lane >> 4; const int e0 = w * 32;
    bf16x8 vf[2][2];
#pragma unroll
    for (int et = 0; et < 2; ++et)
#pragma unroll
        for (int ks = 0; ks < 2; ++ks) { const LAS unsigned char* p = VT + (ks * 32 + quad * 8 + (i >> 2)) * 544 + (e0 + et * 16 + 4 * (i & 3)) * 2; vf[et][ks] = cat8(trread(p), trread(p + 4 * 544)); }
    f32x4 acc[8][2];
#pragma unroll
    for (int dt = 0; dt < 8; ++dt) { acc[dt][0] = (f32x4){0.f, 0.f, 0.f, 0.f}; acc[dt][1] = (f32x4){0.f, 0.f, 0.f, 0.f};
#pragma unroll
        for (int ks = 0; ks < 2; ++ks) { const bf16x8 kf = *(const LAS bf16x8*)(KD + (dt * 16 + i) * 144 + (ks * 32 + quad * 8) * 2);
            acc[dt][0] = MFMA16(kf, vf[0][ks], acc[dt][0]); acc[dt][1] = MFMA16(kf, vf[1][ks], acc[dt][1]); } }
    bf16* Ut = (bf16*)(P.ws + WS_U) + (size_t)item * 256 * 128;
#pragma unroll
    for (int dt = 0; dt < 8; ++dt)
#pragma unroll
        for (int et = 0; et < 2; ++et) { const f32x4 a = acc[dt][et]; v2u o; o.x = pk2(a[0], a[1]); o.y = pk2(a[2], a[3]);
            *(v2u*)(Ut + (size_t)(e0 + et * 16 + i) * 128 + dt * 16 + quad * 4) = o; }
}
__device__ __forceinline__ void gla_scan(const Params& P, int tid, int cu, int ncu) {
    const bf16* Ut = (const bf16*)(P.ws + WS_U); bf16* St = (bf16*)(P.ws + WS_Y); const float* dv = (const float*)(P.ws + WS_DV);
    const int NW = 16 * 8192, half = NW / 2;
    for (int wk = cu * NTHR + tid; wk < half; wk += ncu * NTHR) {
        const int wa = wk, wb = wk + half;
        const int bha = wa >> 13, pa = wa & 8191, bhb = wb >> 13, pb = wb & 8191; const int da = (pa & 31) * 4, db = (pb & 31) * 4;
        float a0 = 0.f, a1 = 0.f, a2 = 0.f, a3 = 0.f, b0 = 0.f, b1 = 0.f, b2 = 0.f, b3 = 0.f;
        const size_t basea = (size_t)bha * 64 * 32768 + (size_t)pa * 4, baseb = (size_t)bhb * 64 * 32768 + (size_t)pb * 4;
#pragma unroll 8
        for (int n = 0; n < 64; ++n) {
            const v2u ua = *(const v2u*)(Ut + basea + (size_t)n * 32768), ub = *(const v2u*)(Ut + baseb + (size_t)n * 32768);
            const f32x4 dda = *(const f32x4*)(dv + (size_t)(bha * 64 + n) * 128 + da), ddb = *(const f32x4*)(dv + (size_t)(bhb * 64 + n) * 128 + db);
            v2u oa, ob; oa.x = pk2(a0, a1); oa.y = pk2(a2, a3); ob.x = pk2(b0, b1); ob.y = pk2(b2, b3);
            *(v2u*)(St + basea + (size_t)n * 32768) = oa; *(v2u*)(St + baseb + (size_t)n * 32768) = ob;
            a0 = a0 * dda[0] + bf_lo(ua.x); a1 = a1 * dda[1] + bf_hi(ua.x); a2 = a2 * dda[2] + bf_lo(ua.y); a3 = a3 * dda[3] + bf_hi(ua.y);
            b0 = b0 * ddb[0] + bf_lo(ub.x); b1 = b1 * ddb[1] + bf_hi(ub.x); b2 = b2 * ddb[2] + bf_lo(ub.y); b3 = b3 * ddb[3] + bf_hi(ub.y);
        }
    }
}
__device__ __forceinline__ void gla_step3(const Params& P, int l, LAS unsigned char* lds, int item, int tid) {
    const int bh = item >> 6, n = item & 63, b = bh >> 2, h = bh & 3; const int t0 = b * SEQ + n * 64;
    const bf16* z = (const bf16*)(P.ws + WS_Z); const float* zs = (const float*)(P.ws + WS_ZS);
    LAS unsigned char* QT = lds; LAS unsigned char* KT = lds + 17408; LAS unsigned char* VT = lds + 34816; LAS unsigned char* ST = lds + 69632; LAS unsigned char* PL = lds + 139264;
    LAS float* GD = (LAS float*)(lds + 139264); LAS float* TOT = (LAS float*)(lds + 139264 + 4096); LAS float* PART = (LAS float*)(lds + 148480);
    const int d = tid & 127, rg = tid >> 7;
    const int lane = tid & 63, w = tid >> 6, i = lane & 15, quad = lane >> 4; const int e0 = w * 32;
    f32x4 gdr = (f32x4){0.f, 0.f, 0.f, 0.f}; if (tid < 256) gdr = *(const f32x4*)(zs + (size_t)t0 * 32 + (tid >> 2) * 32 + (tid & 3) * 4);
    float wv[16]; { const float* wup = P.w_gk_up + (size_t)l * 16 * 512 + h * 128;
#pragma unroll
      for (int r = 0; r < 16; ++r) wv[r] = wup[r * 512 + d]; }
    const float bias = P.b_gk[l * 512 + h * 128 + d];
    bf16 qraw[16], kraw[16];
#pragma unroll
    for (int c = 0; c < 16; ++c) { const size_t zo = (size_t)(t0 + rg * 16 + c) * ZP + h * 128 + d; qraw[c] = z[zo + ZC_GQ]; kraw[c] = z[zo + ZC_GK]; }
    v4u vr[4]; load_v(z + (size_t)t0 * ZP + ZC_GV + h * 256, tid, vr);
    bf16x8 sfr[2][4];
    { const bf16* St = (const bf16*)(P.ws + WS_Y) + (size_t)item * 32768;
#pragma unroll
      for (int et = 0; et < 2; ++et)
#pragma unroll
          for (int ks = 0; ks < 4; ++ks) sfr[et][ks] = *(const bf16x8*)(St + (size_t)(e0 + et * 16 + i) * 128 + ks * 32 + quad * 8); }
    __syncthreads();
    if (tid < 256) *(LAS f32x4*)(GD + (tid >> 2) * 16 + (tid & 3) * 4) = gdr;
    store_v(VT, tid, vr);
    __syncthreads();
    float bv[16], blast;
    gla_decay(GD, TOT, tid, wv, bias, bv, blast);
#pragma unroll
    for (int c = 0; c < 16; ++c) { const int row = rg * 16 + c;
        const float q = bf2f(qraw[c]) * 0.08838834764831845f * __expf(bv[c]), k = bf2f(kraw[c]) * __expf(-bv[c]);
        *(LAS bf16*)(QT + row * 272 + d * 2) = (bf16)f2bf(q); *(LAS bf16*)(KT + row * 272 + d * 2) = (bf16)f2bf(k); }
    __syncthreads();
    { const int cpt = w & 3;
#pragma unroll
      for (int hf = 0; hf < 2; ++hf) { const int ct = 2 * (w >> 2) + hf; f32x4 a4 = (f32x4){0.f, 0.f, 0.f, 0.f};
#pragma unroll
          for (int ks = 0; ks < 4; ++ks) { const bf16x8 ka = *(const LAS bf16x8*)(KT + (cpt * 16 + i) * 272 + (ks * 32 + quad * 8) * 2), qb = *(const LAS bf16x8*)(QT + (ct * 16 + i) * 272 + (ks * 32 + quad * 8) * 2);
              a4 = MFMA16(ka, qb, a4); }
          const int cq = ct * 16 + i, ck = cpt * 16 + quad * 4;
          v2u o; o.x = pk2(ck <= cq ? a4[0] : 0.f, ck + 1 <= cq ? a4[1] : 0.f); o.y = pk2(ck + 2 <= cq ? a4[2] : 0.f, ck + 3 <= cq ? a4[3] : 0.f);
          *(LAS v2u*)(PL + cq * 144 + ck * 2) = o; } }
    __syncthreads();
    f32x4 acc[4][2];
#pragma unroll
    for (int ct = 0; ct < 4; ++ct) { acc[ct][0] = (f32x4){0.f, 0.f, 0.f, 0.f}; acc[ct][1] = (f32x4){0.f, 0.f, 0.f, 0.f}; }
#pragma unroll
    for (int ks = 0; ks < 4; ++ks) { const bf16x8 s0 = sfr[0][ks], s1 = sfr[1][ks];
#pragma unroll
        for (int ct = 0; ct < 4; ++ct) { const bf16x8 qa = *(const LAS bf16x8*)(QT + (ct * 16 + i) * 272 + (ks * 32 + quad * 8) * 2); acc[ct][0] = MFMA16(qa, s0, acc[ct][0]); acc[ct][1] = MFMA16(qa, s1, acc[ct][1]); } }
#pragma unroll
    for (int ks = 0; ks < 2; ++ks) { const LAS unsigned char* p0 = VT + (ks * 32 + quad * 8 + (i >> 2)) * 544 + (e0 + 4 * (i & 3)) * 2;
        const bf16x8 v0 = cat8(trread(p0), trread(p0 + 4 * 544)), v1 = cat8(trread(p0 + 32), trread(p0 + 32 + 4 * 544));
#pragma unroll
        for (int ct = 0; ct < 4; ++ct) { const bf16x8 pa = *(const LAS bf16x8*)(PL + (ct * 16 + i) * 144 + (ks * 32 + quad * 8) * 2); acc[ct][0] = MFMA16(pa, v0, acc[ct][0]); acc[ct][1] = MFMA16(pa, v1, acc[ct][1]); } }
    bf16 gra[4][4], grb[4][4];
#pragma unroll
    for (int ct = 0; ct < 4; ++ct)
#pragma unroll
        for (int j = 0; j < 4; ++j) { const size_t tt = (size_t)(t0 + ct * 16 + quad * 4 + j); gra[ct][j] = z[tt * ZP + ZC_GG + h * 256 + e0 + i]; grb[ct][j] = z[tt * ZP + ZC_GG + h * 256 + e0 + 16 + i]; }
#pragma unroll
    for (int ct = 0; ct < 4; ++ct)
#pragma unroll
        for (int j = 0; j < 4; ++j) { float s = acc[ct][0][j] * acc[ct][0][j] + acc[ct][1][j] * acc[ct][1][j];
            s = row16_sum(s);
            if (i == 0) PART[w * 64 + ct * 16 + quad * 4 + j] = s; }
    __syncthreads();
    if (tid < 64) { float s = 0.f;
#pragma unroll
        for (int ww = 0; ww < 8; ++ww) s += PART[ww * 64 + tid];
        PART[512 + tid] = rsqrtf(s * (1.0f / 256.0f) + 1e-6f); }
    __syncthreads();
    const float* gain = P.gla_norm_gain + l * 256; const float g0 = gain[e0 + i], g1 = gain[e0 + 16 + i];
    bf16* mix = (bf16*)(P.ws + WS_XB);
#pragma unroll
    for (int ct = 0; ct < 4; ++ct)
#pragma unroll
        for (int j = 0; j < 4; ++j) { const int c = ct * 16 + quad * 4 + j;
            const float r = PART[512 + c]; const size_t tt = (size_t)(t0 + c);
            const float ga = bf2f(gra[ct][j]), gb = bf2f(grb[ct][j]);
            mix[tt * 2048 + h * 256 + e0 + i] = (bf16)f2bf(acc[ct][0][j] * r * g0 * ga); mix[tt * 2048 + h * 256 + e0 + 16 + i] = (bf16)f2bf(acc[ct][1][j] * r * g1 * gb); }
}
__device__ __forceinline__ void mem_attn(const Params& P, int l, LAS unsigned char* lds, int item, int tid) {
    const int bh = item >> 3, qblk2 = (item & 7) * 2, b = bh >> 2, h = bh & 3;
    const bf16* z = (const bf16*)(P.ws + WS_Z); const bf16* mkv = (const bf16*)(P.ws + WS_MKV); bf16* mix = (bf16*)(P.ws + WS_XB);
    LAS unsigned char* KS = lds; LAS unsigned char* VS = lds + 69632;
    v4u kr[8], vr[8];
#pragma unroll
    for (int i = 0; i < 8; ++i) { const int idx = tid + 512 * i, key = idx >> 4, ch = idx & 15; const bf16* src = mkv + (size_t)(b * MEMLEN + key) * 2048 + l * 1024 + h * 128 + ch * 8; kr[i] = *(const v4u*)src; vr[i] = *(const v4u*)(src + 512); }
    __syncthreads();
#pragma unroll
    for (int i = 0; i < 8; ++i) { const int idx = tid + 512 * i, key = idx >> 4, ch = idx & 15; *(LAS v4u*)(KS + key * 272 + ch * 16) = kr[i]; *(LAS v4u*)(VS + key * 288 + ch * 16) = vr[i]; }
    __syncthreads();
    const int lane = tid & 63, w = tid >> 6, i = lane & 15, quad = lane >> 4;
    for (int pass = 0; pass < 4; ++pass) {
        const int q0 = (qblk2 + (pass >> 1)) * 256 + w * 32 + (pass & 1) * 16; const size_t tt = (size_t)(b * SEQ + q0 + i);
        bf16x8 qf[4];
#pragma unroll
        for (int ks = 0; ks < 4; ++ks) qf[ks] = *(const bf16x8*)(z + tt * ZP + ZC_MQ + h * 128 + ks * 32 + quad * 8);
        f32x4 sa[16];
#pragma unroll
        for (int kt = 0; kt < 16; ++kt) { sa[kt] = (f32x4){0.f, 0.f, 0.f, 0.f};
#pragma unroll
            for (int ks = 0; ks < 4; ++ks) { const bf16x8 ka = *(const LAS bf16x8*)(KS + (kt * 16 + i) * 272 + (ks * 32 + quad * 8) * 2); sa[kt] = MFMA16(ka, qf[ks], sa[kt]); }
            if (kt & 1) __builtin_amdgcn_sched_barrier(0); }
        float mx = -INFINITY;
#pragma unroll
        for (int kt = 0; kt < 16; ++kt) mx = fmaxf(fmaxf(fmaxf(sa[kt][0], sa[kt][1]), fmaxf(sa[kt][2], sa[kt][3])), mx);
        mx = fmaxf(mx, __shfl_xor(mx, 16)); mx = fmaxf(mx, __shfl_xor(mx, 32));
        const float sc = 0.08838834764831845f * 1.4426950408889634f; float lsum = 0.f;
#pragma unroll
        for (int kt = 0; kt < 16; ++kt)
#pragma unroll
            for (int j = 0; j < 4; ++j) { const float p = __builtin_amdgcn_exp2f((sa[kt][j] - mx) * sc); sa[kt][j] = p; lsum += p; }
        lsum += __shfl_xor(lsum, 16); lsum += __shfl_xor(lsum, 32);
        f32x4 oa[8];
#pragma unroll
        for (int et = 0; et < 8; ++et) oa[et] = (f32x4){0.f, 0.f, 0.f, 0.f};
#pragma unroll
        for (int s = 0; s < 8; ++s) { v4u pw; pw.x = pk2(sa[2 * s][0], sa[2 * s][1]); pw.y = pk2(sa[2 * s][2], sa[2 * s][3]); pw.z = pk2(sa[2 * s + 1][0], sa[2 * s + 1][1]); pw.w = pk2(sa[2 * s + 1][2], sa[2 * s + 1][3]);
            const bf16x8 pb = __builtin_bit_cast(bf16x8, pw);
            const LAS unsigned char* vp = VS + (32 * s + quad * 4 + (i >> 2)) * 288 + (4 * (i & 3)) * 2;
#pragma unroll
            for (int et = 0; et < 8; ++et) { const bf16x8 va = cat8(trread(vp + et * 32), trread(vp + et * 32 + 16 * 288)); oa[et] = MFMA16(va, pb, oa[et]); }
            __builtin_amdgcn_sched_barrier(0); }
        const float rl = 1.0f / lsum;
#pragma unroll
        for (int et = 0; et < 8; ++et) { const int e = et * 16 + quad * 4; const v2u g = *(const v2u*)(z + tt * ZP + ZC_MG + h * 128 + e);
            v2u o; o.x = pk2(oa[et][0] * rl * bf_lo(g.x), oa[et][1] * rl * bf_hi(g.x)); o.y = pk2(oa[et][2] * rl * bf_lo(g.y), oa[et][3] * rl * bf_hi(g.y));
            *(v2u*)(mix + tt * 2048 + 1536 + h * 128 + e) = o; }
    }
}
__device__ __forceinline__ void fox_seg(const Params& P, int l, int item, LAS float* scr, int tid) {
    const int bh = item >> 3, seg = item & 7, b = bh >> 3, h = bh & 7, pos = seg * 512 + tid;
    const float* zs = (const float*)(P.ws + WS_ZS); const bf16* z = (const bf16*)(P.ws + WS_Z); float* ft = (float*)(P.ws + WS_FOXT);
    const float lf = logsig(zs[(size_t)(b * SEQ + pos) * 32 + 16 + h] + P.b_f[l * 8 + h]);
    const bf16* zr = z + (size_t)(b * SEQ + pos) * ZP + h * 64; float sq = 0.f, sk = 0.f;
#pragma unroll
    for (int c = 0; c < 8; ++c) { const v4u a = *(const v4u*)(zr + ZC_FQ + c * 8), k4 = *(const v4u*)(zr + ZC_FK + c * 8);
#pragma unroll
        for (int e = 0; e < 4; ++e) { const float a0 = bf_lo(a[e]), a1 = bf_hi(a[e]), k0 = bf_lo(k4[e]), k1 = bf_hi(k4[e]); sq += a0 * a0 + a1 * a1; sk += k0 * k0 + k1 * k1; } }
    const int lane = tid & 63, w = tid >> 6; float inc = lf;
#pragma unroll
    for (int o = 1; o < 64; o <<= 1) { const float t = __shfl_up(inc, o); if (lane >= o) inc += t; }
#pragma unroll
    for (int o = 1; o < 64; o <<= 1) { sq = fmaxf(sq, __shfl_xor(sq, o)); sk = fmaxf(sk, __shfl_xor(sk, o)); }
    __syncthreads();
    if (lane == 63) { scr[w] = inc; scr[8 + w] = sq; scr[16 + w] = sk; }
    __syncthreads();
    float off = 0.f;
#pragma unroll
    for (int ww = 0; ww < 8; ++ww) if (ww < w) off += scr[ww];
    ft[FT_CBL + bh * 4096 + pos] = inc + off;
    if (tid == 511) ft[FT_SEG + bh * 8 + seg] = inc + off;
    if (tid == 0) { ft[FT_QNB + bh * 16 + 2 * seg] = fmaxf(fmaxf(scr[8], scr[9]), fmaxf(scr[10], scr[11])); ft[FT_QNB + bh * 16 + 2 * seg + 1] = fmaxf(fmaxf(scr[12], scr[13]), fmaxf(scr[14], scr[15]));
        float km = 0.f;
#pragma unroll
        for (int ww = 0; ww < 8; ++ww) km = fmaxf(km, scr[16 + ww]);
        ft[FT_KNS + bh * 8 + seg] = km; }
}
__device__ __forceinline__ void fox_bias(const Params& P, int bh, LAS float* cb, LAS float* wtot, int tid) {
    const float* ft = (const float*)(P.ws + WS_FOXT); const int w = tid >> 6;
    float off = 0.f, km = 0.f;
#pragma unroll
    for (int sg = 0; sg < 8; ++sg) { const float t = ft[FT_SEG + bh * 8 + sg]; if (sg < w) off += t; km = fmaxf(km, ft[FT_KNS + bh * 8 + sg]); }
    const f32x4 c0 = *(const f32x4*)(ft + FT_CBL + bh * 4096 + tid * 8), c1 = *(const f32x4*)(ft + FT_CBL + bh * 4096 + tid * 8 + 4);
    *(LAS f32x4*)(cb + tid * 8) = (c0 + off) * -1.4426950408889634f; *(LAS f32x4*)(cb + tid * 8 + 4) = (c1 + off) * -1.4426950408889634f;
    if (tid < 16) wtot[8 + tid] = ft[FT_QNB + bh * 16 + tid];
    if (tid == 16) wtot[24] = km;
    __syncthreads();
}
#define FOX_MARGIN 50.0f
__device__ __forceinline__ int fox_skip(const LAS float* cb, const LAS float* wtot, int qb, int tid) {
    const float qn = wtot[8 + qb], kn = wtot[24];
    const float smax = sqrtf(qn) * sqrtf(kn) * 1.0001f + 1e-3f;
    const int lane = tid & 63; const float thr = cb[qb * 256] - 2.0f * smax - FOX_MARGIN;
    const unsigned long long m = __ballot(cb[lane * 64 + 63] <= thr);
    int t0 = __builtin_popcountll(m) & ~1; const int nt = 4 * qb + 4; if (t0 > nt - 4) t0 = nt - 4;
    return __builtin_amdgcn_readfirstlane(t0);
}
__device__ __forceinline__ void side_gemm(const Params& P, int l, int tid, int G) {
    const bf16* XBp = (const bf16*)(P.ws + WS_XB); const bf16* Wt = (const bf16*)(P.ws + WS_WIN) + (size_t)l * NZ * 2048 + (size_t)12288 * 2048;
    float* zs = (float*)(P.ws + WS_ZS);
    const int lane = tid & 63, w = tid >> 6, i = lane & 15, quad = lane >> 4;
    for (int blk = blockIdx.x; blk < T / 64; blk += G) {
        const int row0 = blk * 64 + (w >> 1) * 16, ct = w & 1;
        const bf16* ap = XBp + (size_t)(row0 + i) * 2048 + quad * 8; const bf16* bp = Wt + (size_t)(ct * 16 + i) * 2048 + quad * 8;
        f32x4 acc = (f32x4){0.f, 0.f, 0.f, 0.f};
#pragma unroll 16
        for (int ks = 0; ks < 64; ++ks) { const bf16x8 a = *(const bf16x8*)(ap + ks * 32), b = *(const bf16x8*)(bp + ks * 32); acc = MFMA16(a, b, acc); }
#pragma unroll
        for (int j = 0; j < 4; ++j) { const int row = row0 + quad * 4 + j; zs[(size_t)row * 32 + ct * 16 + i] = acc[j]; }
    }
}
__device__ __forceinline__ void final_norm(const Params& P, int tid, int G) {
    const int lane = tid & 63, wave = tid >> 6; const float* ss = (const float*)(P.ws + WS_SS) + 2 * T;
    for (int m = blockIdx.x * NWAVES + wave; m < T; m += G * NWAVES) { const float r = rsqrtf(ss[m] * (1.0f / 2048.0f) + 1e-6f);
        f32x4* xr = (f32x4*)(P.out + (size_t)m * DM) + lane; const f32x4* gr = (const f32x4*)P.final_gain + lane;
#pragma unroll
        for (int j = 0; j < 8; ++j) { const f32x4 v = xr[64 * j], g = gr[64 * j]; xr[64 * j] = v * r * g; } }
}

#ifndef P1_ALIGN
#define P1_ALIGN true
#endif
#ifndef P1_SP2
#define P1_SP2 true
#endif
#ifndef REPEAT_MASK
#define REPEAT_MASK 0
#endif
__global__ void __launch_bounds__(NTHR, 2) fwd_mega(Params P) {
    extern __shared__ __attribute__((aligned(16))) unsigned char lds_raw[];
    cg::grid_group grid = cg::this_grid();
    LAS unsigned char* lds = (LAS unsigned char*)lds_raw;
    const int tid = threadIdx.x, G = gridDim.x, bx = blockIdx.x;
    unsigned char* ws = P.ws;
    volatile LAS unsigned* bst = (volatile LAS unsigned*)(lds + LDS_BYTES - 16);
    if (tid < 4) bst[tid] = 0u;
    __syncthreads();
    XcdBarrier xbar = xcd_barrier_post((unsigned*)(ws + WS_CTL), bst);
    bf16* XB = (bf16*)(ws + WS_XB); bf16* Z = (bf16*)(ws + WS_Z); float* ZS = (float*)(ws + WS_ZS); float* SS = (float*)(ws + WS_SS);

    for (int rep_ = 0; rep_ < 1 + ((REPEAT_MASK >> 7) & 1); ++rep_)
    { int tp = tid; asm volatile("" : "+v"(tp)); phase_prologue(P, lds, tp, G); }
    if (P.out == nullptr) grid.sync();
    xcd_barrier(xbar);
    for (int l = 0; l < DEPTH; ++l) {
        for (int rep_ = 0; rep_ < 1 + ((REPEAT_MASK >> 5) & 1); ++rep_)
        { pg8::Gemm g{XB, (const bf16*)(ws + WS_WIN) + (size_t)l * NZ * 2048, T, ZP, 2048}; pg8::StaticOrder S; S.init(T, ZP, G, bx);
          pg8::EpiZ E{Z, ZP, 0};
          pg8::gemm_phase<pg8::EpiZ, pg8::StaticOrder, P1_ALIGN, P1_SP2>(lds, g, S, E); }
        { int tp = tid; asm volatile("" : "+v"(tp)); side_gemm(P, l, tp, G); }
        if (l == 0) { pg8::Gemm g{(const bf16*)(ws + WS_MEMB), (const bf16*)(ws + WS_WKV), MROWS, 2048, 2048}; pg8::TailOrder S{bx, G - 32, 4};
          pg8::EpiZ E{(bf16*)(ws + WS_MKV), 2048, 1};
          pg8::gemm_phase<pg8::EpiZ, pg8::TailOrder, true, true>(lds, g, S, E); }
        xcd_barrier(xbar);
        for (int rep_ = 0; rep_ < 1 + ((REPEAT_MASK >> 0) & 1); ++rep_)
        { G1Pre R1; int tp = tid; asm volatile("" : "+v"(tp));
          if (bx < 1024) gla_step1_pre(P, bx, tp, R1);
          for (int it = bx; it < 1024; it += G) { asm volatile("" : "+v"(tp)); gla_step1(P, l, lds, it, it + G < 1024 ? it + G : -1, tp, R1); } }
        xcd_barrier(xbar);
        { const int hg = G >> 1;
          if (bx < hg) { int tp = tid; asm volatile("" : "+v"(tp)); gla_scan(P, tp, bx, hg);
              for (int it = bx; it < 256; it += hg) { asm volatile("" : "+v"(tp)); fox_seg(P, l, it, (LAS float*)lds, tp); } }
          else for (int it = bx - hg; it < 128; it += G - hg) { int tp = tid; asm volatile("" : "+v"(tp)); mem_attn(P, l, lds, it, tp); } }
        xcd_barrier(xbar);
        for (int rep_ = 0; rep_ < 1 + ((REPEAT_MASK >> 3) & 1); ++rep_)
        { const int vcu = (G % 8 == 0) ? (bx % 8) * (G / 8) + bx / 8 : bx;
          for (int pr = vcu; pr < 256; pr += G) { const int bh = pr >> 3, s = pr & 7, b = bh >> 3, h = bh & 7;
              __syncthreads();
              { int tp = tid; asm volatile("" : "+v"(tp)); fox_bias(P, bh, (LAS float*)(lds + 86016), (LAS float*)(lds + 102400), tp); }
              for (int k = 0; k < 2; ++k) { const int qb = k == 0 ? 15 - s : s; const int t0s = fox_skip((const LAS float*)(lds + 86016), (const LAS float*)(lds + 102400), qb, tid);
                  attn_body::attn_unit<40>(b, h, qb, (const attn_body::bf16*)(Z + ZC_FQ), (const attn_body::bf16*)(Z + ZC_FK), (const attn_body::bf16*)(Z + ZC_FV), (attn_body::bf16*)(XB + 1024),
                                          (const attn_body::bf16*)(Z + ZC_FG), (attn_body::lds_f4p)(lds + 86016), t0s, (char*)lds_raw); } } }
        for (int rep_ = 0; rep_ < 1 + ((REPEAT_MASK >> 4) & 1); ++rep_)
        for (int it = bx; it < 1024; it += G) { int tp = tid; asm volatile("" : "+v"(tp)); gla_step3(P, l, lds, it, tp); }
        xcd_barrier(xbar);
        for (int rep_ = 0; rep_ < 1 + ((REPEAT_MASK >> 6) & 1); ++rep_)
        { pg8::Gemm g{XB, (const bf16*)(ws + WS_WBR) + (size_t)l * 2048 * 2048, T, 2048, 2048}; pg8::StaticOrder S; S.init(T, 2048, G, bx);
          pg8::EpiY E{(bf16*)(ws + WS_Y), Z + ZC_MERGE, ZP};
          pg8::gemm_phase<pg8::EpiY, pg8::StaticOrder, true, true>(lds, g, S, E); }
        xcd_barrier(xbar);
        { pg8::Gemm g{(const bf16*)(ws + WS_Y), (const bf16*)(ws + WS_WOUT) + (size_t)l * 2048 * 2048, T, 2048, 2048}; pg8::StaticOrder S; S.init(T, 2048, G, bx);
          unsigned* pcnt = (unsigned*)(ws + WS_CTL + 16384) + l * 4096;
          if (G == 256 && l == DEPTH - 1) { pg8::EpiXF<true> E{P.out, P.out, nullptr, SS + (l + 1) * T, pcnt, P.final_gain};
              pg8::gemm_phase<pg8::EpiXF<true>, pg8::StaticOrder, true, true>(lds, g, S, E); }
          else if (G == 256) { pg8::EpiXF<false> E{l == 0 ? P.x : P.out, P.out, XB, SS + (l + 1) * T, pcnt, nullptr};
              pg8::gemm_phase<pg8::EpiXF<false>, pg8::StaticOrder, true, true>(lds, g, S, E); }
          else { pg8::EpiX E{l == 0 ? P.x : P.out, P.out, l == DEPTH - 1 ? nullptr : XB, SS + (l + 1) * T};
              pg8::gemm_phase<pg8::EpiX, pg8::StaticOrder, true, true>(lds, g, S, E); } }
        if (!(l == DEPTH - 1 && G == 256)) xcd_barrier(xbar);
        if (G != 256 && l < DEPTH - 1) { int tp = tid; asm volatile("" : "+v"(tp)); rescale_rows(XB, SS + (l + 1) * T, tp, G); xcd_barrier(xbar); }
    }
    if (G == 256) return;
#ifdef EXTRA_SYNCS
    for (int k_ = 0; k_ < EXTRA_SYNCS; ++k_) xcd_barrier(xbar);
#endif
    { int tp = tid; asm volatile("" : "+v"(tp)); final_norm(P, tp, G); }
}

extern "C" void kernel_launch(void* const* d_in, const int* in_sizes, int n_in, void* d_out, int out_size, void* d_ws, size_t ws_size, hipStream_t stream) {
    static int grid = 0;
    if (grid == 0) {
        if (n_in != 13 || ws_size < WS_END) { fprintf(stderr, "kernel_launch: need 13 inputs and >= %zu bytes of workspace (got %d, %zu)\n", (size_t)WS_END, n_in, ws_size); grid = -1; return; }
        int dev = 0, cus = 0, per_cu = 0;
        (void)hipGetDevice(&dev); (void)hipDeviceGetAttribute(&cus, hipDeviceAttributeMultiprocessorCount, dev);
        if (hipFuncSetAttribute((const void*)fwd_mega, hipFuncAttributeMaxDynamicSharedMemorySize, LDS_BYTES) != hipSuccess) { fprintf(stderr, "kernel_launch: hipFuncSetAttribute failed\n"); grid = -1; return; }
        if (hipOccupancyMaxActiveBlocksPerMultiprocessor(&per_cu, (const void*)fwd_mega, NTHR, LDS_BYTES) != hipSuccess || per_cu < 1) { fprintf(stderr, "kernel_launch: occupancy query says %d blocks/CU\n", per_cu); per_cu = 1; }
        (void)hipGetLastError();
        grid = cus;
    }
    if (grid < 0) return;
    Params p{};
    p.x = (const float*)d_in[0]; p.mem = (const float*)d_in[1]; p.norm_gain = (const float*)d_in[2]; p.w_in = (const float*)d_in[3]; p.w_gk_up = (const float*)d_in[4];
    p.b_gk = (const float*)d_in[5]; p.gla_norm_gain = (const float*)d_in[6]; p.b_f = (const float*)d_in[7]; p.mem_norm_gain = (const float*)d_in[8]; p.w_mem_kv = (const float*)d_in[9];
    p.w_branch = (const float*)d_in[10]; p.w_out = (const float*)d_in[11]; p.final_gain = (const float*)d_in[12];
    p.out = (float*)d_out; p.ws = (unsigned char*)d_ws;
    if (hipMemsetAsync((char*)d_ws + WS_CTL, 0, CTL_ZERO_BYTES, stream) != hipSuccess) { fprintf(stderr, "kernel_launch: memset failed\n"); return; }
    void* args[] = {&p};
    hipError_t e = hipLaunchCooperativeKernel((const void*)fwd_mega, dim3(grid), dim3(NTHR), args, LDS_BYTES, stream);
    if (e != hipSuccess) fprintf(stderr, "kernel_launch: cooperative launch failed: %s (grid %d)\n", hipGetErrorString(e), grid);
}
```

```cpp
#define PG8_ROT 1
#include <hip/hip_runtime.h>
#include <hip/hip_cooperative_groups.h>
#include <hip/hip_bf16.h>
#include <cstdio>
#include <cstdint>
#include <cmath>
namespace cg = cooperative_groups;
namespace pg8 {
#define PG8_LAS __attribute__((address_space(3)))
typedef unsigned short bf16_t;
typedef short bf16x8 __attribute__((ext_vector_type(8)));
typedef float f32x4 __attribute__((ext_vector_type(4)));
typedef unsigned u32x4 __attribute__((ext_vector_type(4)));
constexpr int BM = 256, BK = 64, HALF = 128, HTB = HALF * BK * 2  , STAGE_BYTES = 8 * HTB, NXCD = 8;
#ifndef PG8_WGM
#define PG8_WGM 4
#endif
constexpr int WGM = PG8_WGM;

__host__ __device__ __forceinline__ int lds_byte(int r, int c) { const int st = (r >> 4) * 2 + (c >> 5), rr = r & 15, cc = c & 31, ob = rr * 64 + cc * 2; return st * 1024 + (ob ^ (((ob >> 9) & 1) << 5)); }
__host__ __device__ __forceinline__ void stage_rc(int b, int& R, int& C) { const int st = b / 1024, sb = b % 1024, swz = sb ^ (((sb >> 9) & 1) << 5); R = (st >> 1) * 16 + swz / 64; C = (st & 1) * 32 + (swz % 64) / 2; }
__host__ __device__ __forceinline__ int perm32(int rho) { const int n = rho >> 4, i = rho & 15; return 8 * (i >> 2) + 4 * n + (i & 3); }

struct Unit { int pm, pn; };
struct Gemm { const bf16_t* A; const bf16_t* Bt; int M, N, K; };

struct StaticOrder {
    int nM, nN, nwg, G, c;
    __host__ __device__ void init(int M, int N, int G_, int c_) { nM = M / BM; nN = N / BM; nwg = nM * nN; G = G_; c = c_; }
    __host__ __device__ bool next(int i, Unit& u) const {
        const long L = (long)i * G + c; if (L >= nwg) return false;
        int wgid = (int)L; const int xcd_ = wgid % NXCD; { const int q = nwg / NXCD, r = nwg % NXCD, xcd = wgid % NXCD, off = wgid / NXCD; wgid = (xcd < r ? xcd * (q + 1) : r * (q + 1) + (xcd - r) * q) + off; }
        const int nig = WGM * nN, gid = wgid / nig, fm = gid * WGM, gsz = (nM - fm) < WGM ? (nM - fm) : WGM;
        u.pm = fm + ((wgid % nig) % gsz); u.pn = (wgid % nig) / gsz;
#ifdef PG8_ROT
        if (nN >= 16) { u.pn += xcd_ * (nN / NXCD); if (u.pn >= nN) u.pn -= nN; }
#endif
        return true;
    }
    __device__ __forceinline__ void a_ready(const Unit&) const {}
    __device__ __forceinline__ void done(const Unit&) const {}
};

typedef float f32x2e_t __attribute__((ext_vector_type(2))); typedef __bf16 bf16x2e_t __attribute__((ext_vector_type(2)));
__device__ __forceinline__ unsigned cvt_pk_bf16(float lo, float hi) { const f32x2e_t v = {lo, hi}; return __builtin_bit_cast(unsigned, __builtin_convertvector(v, bf16x2e_t)); }
__device__ __forceinline__ float bf_lo(unsigned u) { return __uint_as_float(u << 16); }
__device__ __forceinline__ float bf_hi(unsigned u) { return __uint_as_float(u & 0xffff0000u); }
__device__ __forceinline__ float fsigmoid(float v) { return __builtin_amdgcn_rcpf(1.f + __expf(-v)); }

struct EpiZ {
    static constexpr bool PERM = true, AFTER_DRAIN = false, HAS_MID = false; static constexpr int MID0 = -1, MID1 = -1;
    bf16_t* Z; int ldz; int kind;
    __device__ __forceinline__ void mid(f32x4 (&acc)[2][2][4][2], const Unit& u, int wr, int wc, int fr, int fq, int which) const {}
    __device__ __forceinline__ void operator()(const f32x4 (&acc)[2][2][4][2], const Unit& u, int wr, int wc, int fr, int fq) const {
        const int row0 = u.pm * BM + wr * 64 + fr;
        int mode = 0; const int pn = u.pn;
        if (kind == 0) {
            if (pn >= 24) mode = 3;
            else if ((pn >= 8 && pn < 12) || pn == 18 || pn == 19 || pn == 22 || pn == 23) mode = 2;
            else if (pn == 12 || pn == 13) mode = 1;
        }
        const int col0 = pn * BM + wc * 32 + 8 * fq;
#pragma unroll
        for (int ai = 0; ai < 2; ++ai)
#pragma unroll
            for (int m = 0; m < 4; ++m) { bf16_t* rowp = Z + (size_t)(row0 + ai * HALF + m * 16) * ldz + col0;
#pragma unroll
                for (int bj = 0; bj < 2; ++bj) { f32x4 v0 = acc[ai][bj][m][0], v1 = acc[ai][bj][m][1];
                    if (mode == 1) { v0 = v0 * 0.18033688011112042f; v1 = v1 * 0.18033688011112042f; }
                    else if (mode == 2) {
#pragma unroll
                        for (int j = 0; j < 4; ++j) { v0[j] = v0[j] * fsigmoid(v0[j]); v1[j] = v1[j] * fsigmoid(v1[j]); } }
                    else if (mode == 3) {
#pragma unroll
                        for (int j = 0; j < 4; ++j) { v0[j] = fsigmoid(v0[j]); v1[j] = fsigmoid(v1[j]); } }
                    u32x4 w; w.x = cvt_pk_bf16(v0[0], v0[1]); w.y = cvt_pk_bf16(v0[2], v0[3]); w.z = cvt_pk_bf16(v1[0], v1[1]); w.w = cvt_pk_bf16(v1[2], v1[3]);
                    *(u32x4*)(rowp + bj * HALF) = w; } }
    }
};

struct EpiY {
    static constexpr bool PERM = true, AFTER_DRAIN = false, HAS_MID = true; static constexpr int MID0 = 16, MID1 = 24;
    bf16_t* Y; const bf16_t* Zg; int ldz;
    __device__ __forceinline__ void mid(f32x4 (&acc)[2][2][4][2], const Unit& u, int wr, int wc, int fr, int fq, int which) const {
        int row0 = u.pm * BM + wr * 64 + fr; asm volatile("" : "+v"(row0)); const int col0 = u.pn * BM + wc * 32 + 8 * fq + which * 2048;
#pragma unroll
        for (int ai = 0; ai < 2; ++ai) {
            u32x4 ga[4][2], gb[4][2];
#pragma unroll
            for (int m = 0; m < 4; ++m) { const bf16_t* rowp = Zg + (size_t)(row0 + ai * HALF + m * 16) * ldz + col0;
#pragma unroll
                for (int bj = 0; bj < 2; ++bj) { ga[m][bj] = *(const u32x4*)(rowp + bj * HALF); gb[m][bj] = *(const u32x4*)(rowp + bj * HALF + 2048); } }
#pragma unroll
            for (int m = 0; m < 4; ++m)
#pragma unroll
                for (int bj = 0; bj < 2; ++bj)
#pragma unroll
                    for (int e = 0; e < 4; ++e) { const float r0 = bf_lo(ga[m][bj][e]) * __builtin_amdgcn_rcpf(fmaxf(bf_lo(gb[m][bj][e]), 1e-30f)), r1 = bf_hi(ga[m][bj][e]) * __builtin_amdgcn_rcpf(fmaxf(bf_hi(gb[m][bj][e]), 1e-30f));
                        acc[ai][bj][m][e >> 1][(e & 1) * 2] *= r0; acc[ai][bj][m][e >> 1][(e & 1) * 2 + 1] *= r1; }
            __builtin_amdgcn_sched_barrier(0); }
        asm volatile("s_waitcnt vmcnt(0)" ::: "memory");
    }
    __device__ __forceinline__ void operator()(const f32x4 (&acc)[2][2][4][2], const Unit& u, int wr, int wc, int fr, int fq) const {
        const int row0 = u.pm * BM + wr * 64 + fr, col0 = u.pn * BM + wc * 32 + 8 * fq;
#pragma unroll
        for (int ai = 0; ai < 2; ++ai)
#pragma unroll
            for (int m = 0; m < 4; ++m) { const size_t r = (size_t)(row0 + ai * HALF + m * 16);
#pragma unroll
                for (int bj = 0; bj < 2; ++bj) { const u32x4 g = *(const u32x4*)(Zg + r * ldz + 4096 + col0 + bj * HALF);
                    const f32x4 a0 = acc[ai][bj][m][0], a1 = acc[ai][bj][m][1]; u32x4 w;
                    w.x = cvt_pk_bf16(a0[0] * bf_lo(g.x), a0[1] * bf_hi(g.x)); w.y = cvt_pk_bf16(a0[2] * bf_lo(g.y), a0[3] * bf_hi(g.y));
                    w.z = cvt_pk_bf16(a1[0] * bf_lo(g.z), a1[1] * bf_hi(g.z)); w.w = cvt_pk_bf16(a1[2] * bf_lo(g.w), a1[3] * bf_hi(g.w));
                    *(u32x4*)(Y + r * 2048 + col0 + bj * HALF) = w; }
                __builtin_amdgcn_sched_barrier(0); }
    }
};

struct EpiX {
    static constexpr bool PERM = false, AFTER_DRAIN = false, HAS_MID = false; static constexpr int MID0 = -1, MID1 = -1;
    const float* Xin; float* Xout; bf16_t* XB; float* ssq;
    __device__ __forceinline__ void mid(f32x4 (&acc)[2][2][4][2], const Unit& u, int wr, int wc, int fr, int fq, int which) const {}
    __device__ __forceinline__ void operator()(const f32x4 (&acc)[2][2][4][2], const Unit& u, int wr, int wc, int fr, int fq) const {
        const int row0 = u.pm * BM + wr * 64 + fr, col0 = u.pn * BM + wc * 32 + 4 * fq;
#pragma unroll
        for (int ai = 0; ai < 2; ++ai)
#pragma unroll
            for (int m = 0; m < 4; ++m) { const int row = row0 + ai * HALF + m * 16; const size_t off = (size_t)row * 2048 + col0; float ss = 0.f;
#pragma unroll
                for (int bj = 0; bj < 2; ++bj)
#pragma unroll
                    for (int n = 0; n < 2; ++n) { const size_t o = off + bj * HALF + n * 16; const f32x4 xo = *(const f32x4*)(Xin + o) + acc[ai][bj][m][n];
                        *(f32x4*)(Xout + o) = xo; ss += (xo[0] * xo[0] + xo[1] * xo[1]) + (xo[2] * xo[2] + xo[3] * xo[3]);
                        if (XB) { unsigned long long w = (unsigned long long)cvt_pk_bf16(xo[0], xo[1]) | ((unsigned long long)cvt_pk_bf16(xo[2], xo[3]) << 32); *(unsigned long long*)(XB + o) = w; } }
                ss += __shfl_xor(ss, 16); ss += __shfl_xor(ss, 32);
                if (fq == 0) atomicAdd(ssq + row, ss); }
    }
};
template <bool FINAL> struct EpiXF {
    static constexpr bool PERM = false, AFTER_DRAIN = false, HAS_MID = false; static constexpr int MID0 = -1, MID1 = -1;
    const float* Xin; float* X; bf16_t* XB; float* ssq; unsigned* cnt; const float* fgain;
    __device__ __forceinline__ void mid(f32x4 (&acc)[2][2][4][2], const Unit& u, int wr, int wc, int fr, int fq, int which) const {}
    __device__ __forceinline__ void operator()(f32x4 (&acc)[2][2][4][2], const Unit& u, int wr, int wc, int fr, int fq) const {
        const int row0 = u.pm * BM + wr * 64 + fr, col0 = u.pn * BM + wc * 32 + 4 * fq;
#pragma unroll
        for (int ai = 0; ai < 2; ++ai)
#pragma unroll
            for (int m = 0; m < 4; ++m) { const int row = row0 + ai * HALF + m * 16; const size_t off = (size_t)row * 2048 + col0; float ss = 0.f;
#pragma unroll
                for (int bj = 0; bj < 2; ++bj)
#pragma unroll
                    for (int n = 0; n < 2; ++n) { const f32x4 xo = *(const f32x4*)(Xin + off + bj * HALF + n * 16) + acc[ai][bj][m][n]; acc[ai][bj][m][n] = xo;
                        if (!FINAL) *(f32x4*)(X + off + bj * HALF + n * 16) = xo;
                        ss += (xo[0] * xo[0] + xo[1] * xo[1]) + (xo[2] * xo[2] + xo[3] * xo[3]); }
                ss += __shfl_xor(ss, 16); ss += __shfl_xor(ss, 32);
                if (fq == 0) atomicAdd(ssq + row, ss); }
        asm volatile("s_waitcnt vmcnt(0)" ::: "memory");
        __builtin_amdgcn_s_barrier();
        if (threadIdx.x == 0) { unsigned* c = cnt + 64 * u.pm; __hip_atomic_fetch_add(c, 1u, __ATOMIC_RELAXED, __HIP_MEMORY_SCOPE_AGENT);
            unsigned sp = 0; while (__hip_atomic_load(c, __ATOMIC_RELAXED, __HIP_MEMORY_SCOPE_AGENT) < 8u && ++sp < (1u << 22)) __builtin_amdgcn_s_sleep(2);
            __builtin_amdgcn_fence(__ATOMIC_ACQUIRE, "agent"); }
        asm volatile("s_waitcnt vmcnt(0) lgkmcnt(0)" ::: "memory");
        __builtin_amdgcn_s_barrier();
        asm volatile("" ::: "memory");
        f32x4 gv[2][2];
        if (FINAL) {
#pragma unroll
            for (int bj = 0; bj < 2; ++bj)
#pragma unroll
                for (int n = 0; n < 2; ++n) gv[bj][n] = *(const f32x4*)(fgain + col0 + bj * HALF + n * 16); }
#pragma unroll
        for (int ai = 0; ai < 2; ++ai)
#pragma unroll
            for (int m = 0; m < 4; ++m) { const int row = row0 + ai * HALF + m * 16; const size_t off = (size_t)row * 2048 + col0;
                const float r = rsqrtf(__hip_atomic_load(ssq + row, __ATOMIC_RELAXED, __HIP_MEMORY_SCOPE_AGENT) * (1.0f / 2048.0f) + 1e-6f);
#pragma unroll
                for (int bj = 0; bj < 2; ++bj)
#pragma unroll
                    for (int n = 0; n < 2; ++n) { const f32x4 xo = acc[ai][bj][m][n] * r;
                        if (FINAL) *(f32x4*)(X + off + bj * HALF + n * 16) = xo * gv[bj][n];
                        else { unsigned long long w = (unsigned long long)cvt_pk_bf16(xo[0], xo[1]) | ((unsigned long long)cvt_pk_bf16(xo[2], xo[3]) << 32); *(unsigned long long*)(XB + off + bj * HALF + n * 16) = w; } } }
    }
};
struct TailOrder {
    int c, first, nM;
    __device__ __forceinline__ bool next(int i, Unit& u) const { if (i > 0 || c < first) return false; const int idx = c - first; u.pm = idx % nM; u.pn = idx / nM; return true; }
    __device__ __forceinline__ void a_ready(const Unit&) const {}
    __device__ __forceinline__ void done(const Unit&) const {}
};
template <class Epi, class Sched, bool ALIGN_EPI = false, bool SP2 = false>
__device__ __forceinline__ void gemm_phase(PG8_LAS unsigned char* lds, const Gemm g, const Sched& S, const Epi& E) {
    int tid_ = threadIdx.x; asm volatile("" : "+v"(tid_));
    const int tid = tid_, wid = __builtin_amdgcn_readfirstlane(tid >> 6), lane = tid & 63, wr = wid >> 2, wc = wid & 3, fr = lane & 15, fq = lane >> 4;
    const int K = g.K, nt = K / BK;
    unsigned voffA[2], voffB[2];
#pragma unroll
    for (int i = 0; i < 2; ++i) { int R, C; stage_rc(tid * 16 + i * 8192, R, C); const int Rb = Epi::PERM ? ((R & ~31) + perm32(R & 31)) : R;
        voffA[i] = (unsigned)(R * K + C) * 2u; voffB[i] = (unsigned)(Rb * K + C) * 2u; }
    const size_t kstep = (size_t)(BK * 2);
    const size_t hstep = (size_t)HALF * K * 2;
    const size_t tstep = 2 * hstep;
    const unsigned ldsw = (unsigned)wid * 1024u;
    const int aoff = lds_byte(wr * 64 + fr, fq * 8), boff = lds_byte(wc * 32 + fr, fq * 8);
#define PG8_SA(b, h) (((b) * 2 + (h)) * HTB)
#define PG8_SB(b, h) ((4 + (b) * 2 + (h)) * HTB)
#define PG8_STAGE(bufoff, gbase, voff) do { _Pragma("unroll") for (int _i = 0; _i < 2; ++_i) \
        __builtin_amdgcn_global_load_lds((const unsigned*)((const char*)(gbase) + (voff)[_i]), (PG8_LAS unsigned*)(lds + (bufoff) + ldsw + _i * 8192), 16, 0, 0); } while (0)
#define PG8_LDA(dst, b, h) do { _Pragma("unroll") for (int m = 0; m < 4; ++m) _Pragma("unroll") for (int k = 0; k < 2; ++k) dst[m][k] = *(const PG8_LAS bf16x8*)(lds + PG8_SA(b, h) + aoff + m * 2048 + k * 1024); } while (0)
#define PG8_LDB(dst, b, h) do { _Pragma("unroll") for (int n = 0; n < 2; ++n) _Pragma("unroll") for (int k = 0; k < 2; ++k) dst[n][k] = *(const PG8_LAS bf16x8*)(lds + PG8_SB(b, h) + boff + n * 2048 + k * 1024); } while (0)
#define PG8_MMA(ai, bj, At, Bt) do { __builtin_amdgcn_s_setprio(1); _Pragma("unroll") for (int m = 0; m < 4; ++m) _Pragma("unroll") for (int n = 0; n < 2; ++n) _Pragma("unroll") for (int k = 0; k < 2; ++k) \
        acc[ai][bj][m][n] = __builtin_amdgcn_mfma_f32_16x16x32_bf16(Bt[n][k], At[m][k], acc[ai][bj][m][n], 0, 0, 0); __builtin_amdgcn_s_setprio(0); } while (0)
#define PG8_WAIT_V(n) asm volatile("s_waitcnt vmcnt(" #n ")" ::: "memory")
#define PG8_WAIT_L(n) asm volatile("s_waitcnt lgkmcnt(" #n ")" ::: "memory")
#define PG8_BAR __builtin_amdgcn_s_barrier()
#define PG8_SCHED __builtin_amdgcn_sched_barrier(0)
    Unit cur, nxt; int ui = 0;
    if (!S.next(0, cur)) return;
    f32x4 acc[2][2][4][2];
#pragma unroll
    for (int a = 0; a < 2; ++a)
#pragma unroll
        for (int b = 0; b < 2; ++b)
#pragma unroll
            for (int m = 0; m < 4; ++m)
#pragma unroll
                for (int n = 0; n < 2; ++n) acc[a][b][m][n] = (f32x4){0.f, 0.f, 0.f, 0.f};
    bf16x8 At[4][2], B0[2][2], B1[2][2];
    const char* cA = (const char*)g.A + (size_t)cur.pm * tstep; const char* cB = (const char*)g.Bt + (size_t)cur.pn * tstep;
    S.a_ready(cur);
    if constexpr (SP2) {
        PG8_STAGE(PG8_SB(0, 0), cB, voffB); PG8_STAGE(PG8_SB(0, 1), cB + hstep, voffB); PG8_STAGE(PG8_SA(0, 0), cA, voffA); PG8_STAGE(PG8_SA(0, 1), cA + hstep, voffA);
        if (wr == 1) PG8_BAR;
        PG8_WAIT_V(2); PG8_BAR;
        PG8_STAGE(PG8_SB(1, 0), cB + kstep, voffB); PG8_STAGE(PG8_SA(1, 0), cA + kstep, voffA); PG8_STAGE(PG8_SB(1, 1), cB + hstep + kstep, voffB);
        PG8_WAIT_V(6); PG8_BAR;
    } else {
        PG8_STAGE(PG8_SB(0, 0), cB, voffB); PG8_STAGE(PG8_SA(0, 0), cA, voffA); PG8_STAGE(PG8_SB(0, 1), cB + hstep, voffB); PG8_STAGE(PG8_SA(0, 1), cA + hstep, voffA);
        if (wr == 1) PG8_BAR;
        PG8_WAIT_V(4); PG8_BAR;
        PG8_STAGE(PG8_SB(1, 0), cB + kstep, voffB); PG8_STAGE(PG8_SA(1, 0), cA + kstep, voffA); PG8_STAGE(PG8_SB(1, 1), cB + hstep + kstep, voffB);
        PG8_WAIT_V(6); PG8_BAR;
    }
    for (;;) {
        const bool has_next = S.next(ui + 1, nxt);
        const char* nA = has_next ? (const char*)g.A + (size_t)nxt.pm * tstep : cA; const char* nB = has_next ? (const char*)g.Bt + (size_t)nxt.pn * tstep : cB;
        for (int t = 0; t < nt; t += 2) {
            if constexpr (Epi::HAS_MID) { if (t == Epi::MID0 || t == Epi::MID1) E.mid(acc, cur, wr, wc, fr, fq, t == Epi::MID0 ? 0 : 1); }
            const bool last = (t == nt - 2);
            const char* a1 = cA + (size_t)(t + 1) * kstep;
            const char* a2 = last ? nA : cA + (size_t)(t + 2) * kstep; const char* b2 = last ? nB : cB + (size_t)(t + 2) * kstep;
            const char* a3 = a2 + kstep; const char* b3 = b2 + kstep;
            if (last && has_next) S.a_ready(nxt);
            if constexpr (SP2) {
            PG8_LDB(B0, 0, 0); PG8_LDB(B1, 0, 1); PG8_SCHED; PG8_LDA(At, 0, 0); PG8_STAGE(PG8_SA(1, 1), a1 + hstep, voffA);
            PG8_WAIT_V(8); PG8_WAIT_L(0); PG8_BAR; PG8_MMA(0, 0, At, B0); PG8_MMA(0, 1, At, B1); PG8_BAR; PG8_SCHED;
            PG8_LDA(At, 0, 1); PG8_STAGE(PG8_SB(0, 0), b2, voffB); PG8_STAGE(PG8_SB(0, 1), b2 + hstep, voffB); PG8_STAGE(PG8_SA(0, 0), a2, voffA);
            PG8_WAIT_V(8); PG8_WAIT_L(0); PG8_BAR; PG8_MMA(1, 0, At, B0); PG8_MMA(1, 1, At, B1); PG8_BAR; PG8_SCHED;
            PG8_LDB(B0, 1, 0); PG8_LDB(B1, 1, 1); PG8_SCHED; PG8_LDA(At, 1, 0); PG8_STAGE(PG8_SA(0, 1), a2 + hstep, voffA);
            PG8_WAIT_V(8); PG8_WAIT_L(0); PG8_BAR; PG8_MMA(0, 0, At, B0); PG8_MMA(0, 1, At, B1); PG8_BAR; PG8_SCHED;
            PG8_LDA(At, 1, 1); PG8_STAGE(PG8_SB(1, 0), b3, voffB); PG8_STAGE(PG8_SB(1, 1), b3 + hstep, voffB); PG8_STAGE(PG8_SA(1, 0), a3, voffA);
            PG8_WAIT_V(8); PG8_WAIT_L(0); PG8_BAR; PG8_MMA(1, 0, At, B0); PG8_MMA(1, 1, At, B1); PG8_BAR; PG8_SCHED;
            } else {
            PG8_LDB(B0, 0, 0); PG8_SCHED; PG8_LDA(At, 0, 0); PG8_STAGE(PG8_SA(1, 1), a1 + hstep, voffA);
            PG8_WAIT_L(8); PG8_BAR; PG8_WAIT_L(0); PG8_MMA(0, 0, At, B0); PG8_BAR; PG8_SCHED;
            PG8_LDB(B1, 0, 1); PG8_STAGE(PG8_SB(0, 0), b2, voffB);
            PG8_BAR; PG8_WAIT_L(0); PG8_MMA(0, 1, At, B1); PG8_BAR;
            PG8_LDA(At, 0, 1); PG8_STAGE(PG8_SA(0, 0), a2, voffA);
            PG8_BAR; PG8_WAIT_L(0); PG8_MMA(1, 0, At, B0); PG8_BAR; PG8_SCHED;
            PG8_STAGE(PG8_SB(0, 1), b2 + hstep, voffB);
            PG8_WAIT_V(6); PG8_BAR; PG8_MMA(1, 1, At, B1); PG8_BAR;
            PG8_LDB(B0, 1, 0); PG8_SCHED; PG8_LDA(At, 1, 0); PG8_STAGE(PG8_SA(0, 1), a2 + hstep, voffA);
            PG8_WAIT_L(8); PG8_BAR; PG8_WAIT_L(0); PG8_MMA(0, 0, At, B0); PG8_BAR; PG8_SCHED;
            PG8_LDB(B1, 1, 1); PG8_STAGE(PG8_SB(1, 0), b3, voffB);
            PG8_BAR; PG8_WAIT_L(0); PG8_MMA(0, 1, At, B1); PG8_BAR;
            PG8_LDA(At, 1, 1); PG8_STAGE(PG8_SA(1, 0), a3, voffA);
            PG8_BAR; PG8_WAIT_L(0); PG8_MMA(1, 0, At, B0); PG8_BAR; PG8_SCHED;
            PG8_STAGE(PG8_SB(1, 1), b3 + hstep, voffB);
            PG8_WAIT_V(6); PG8_BAR; PG8_MMA(1, 1, At, B1); PG8_BAR;
            }
        }
        if constexpr (ALIGN_EPI) { if (wr == 0) PG8_BAR; }
        if constexpr (!Epi::AFTER_DRAIN) { E(acc, cur, wr, wc, fr, fq); S.done(cur); }
        if (!has_next) break;
#pragma unroll
        for (int a = 0; a < 2; ++a)
#pragma unroll
            for (int b = 0; b < 2; ++b)
#pragma unroll
                for (int m = 0; m < 4; ++m)
#pragma unroll
                    for (int n = 0; n < 2; ++n) acc[a][b][m][n] = (f32x4){0.f, 0.f, 0.f, 0.f};
        cur = nxt; cA = nA; cB = nB; ++ui;
        if constexpr (ALIGN_EPI) { if (wr == 1) PG8_BAR; }
    }
    PG8_WAIT_V(0);
    if constexpr (!ALIGN_EPI) { if (wr == 0) PG8_BAR; }
    PG8_BAR;
    if constexpr (Epi::AFTER_DRAIN) { E.fused(acc, cur, wr, wc, fr, fq, lds, wid, lane); S.done(cur); }
#undef PG8_SA
#undef PG8_SB
#undef PG8_STAGE
#undef PG8_LDA
#undef PG8_LDB
#undef PG8_MMA
#undef PG8_WAIT_V
#undef PG8_WAIT_L
#undef PG8_BAR
#undef PG8_SCHED
}
}
#include <hip/hip_bf16.h>
#include <cmath>
namespace attn_body {
using bf16=__hip_bfloat16;
using bf16x8=__attribute__((ext_vector_type(8)))short;
using s16x4=__attribute__((ext_vector_type(4)))short;
using f32x16=__attribute__((ext_vector_type(16)))float;
using u32x4=__attribute__((ext_vector_type(4)))unsigned;
constexpr int BATCH=4,NHEAD=8,SEQ=4096,D=64,DM=12288,OPITCH=2048;
constexpr int NW=8,QBLK=32,QB=QBLK*NW,KVBLK=64,NQB=SEQ/QB;
constexpr int ATTN_PITCH=DM, ATTN_UNIT_ROWS=QB;
__device__ __forceinline__ int crow(int r,int hi){return (r&3)+8*(r>>2)+4*hi;}
#define SBAR() __builtin_amdgcn_sched_barrier(0)
__device__ __forceinline__ void cmask(f32x16&p0,f32x16&p1,int jb,int qrel,int hi){
  const float NEG=-INFINITY; int kb=64*jb+4*hi;
  #pragma unroll
  for(int r=0;r<16;++r){int kv=kb+(r&3)+8*(r>>2); if(kv>qrel)p0[r]=NEG; if(kv+32>qrel)p1[r]=NEG;}
}

constexpr int NSLOT=3, SLOTB=8192;
constexpr int LDS_K=0, LDS_V=NSLOT*SLOTB, LDS_WS=2*NSLOT*SLOTB, LDS_OST=LDS_WS+NW*64*4, LDS_BYTES=LDS_OST+NW*4096;
constexpr float C2=0.125f*1.4426950408889634f;
__device__ __forceinline__ void glds16(const void*gsrc,unsigned lds_dst){unsigned keep;
  asm volatile("s_mov_b32 %0, m0\n\ts_mov_b32 m0, %2\n\ts_nop 0\n\tglobal_load_lds_dwordx4 %1, off\n\ts_mov_b32 m0, %0":"=&s"(keep):"v"(gsrc),"s"(lds_dst):"memory");}
__device__ __forceinline__ float max3f(float a,float b,float c){float r;asm("v_max3_f32 %0, %1, %2, %3":"=v"(r):"v"(a),"v"(b),"v"(c));return r;}
__device__ __forceinline__ float max2f(float a,float b){float r;asm("v_max_f32_e32 %0, %1, %2":"=v"(r):"v"(a),"v"(b));return r;}
__device__ __forceinline__ float fadd_s(float a,float b){float r;asm("v_add_f32_e32 %0, %1, %2":"=v"(r):"v"(a),"v"(b));return r;}
__device__ __forceinline__ float fsub_s(float a,float b){float r;asm("v_sub_f32_e32 %0, %1, %2":"=v"(r):"v"(a),"v"(b));return r;}
typedef float f32x2_t __attribute__((ext_vector_type(2))); typedef __bf16 bf16x2_t __attribute__((ext_vector_type(2)));
__device__ __forceinline__ unsigned cvtpk_s(float lo,float hi){f32x2_t v={lo,hi};bf16x2_t b=__builtin_convertvector(v,bf16x2_t);return __builtin_bit_cast(unsigned,b);}
#define WAIT_BAR(N) asm volatile("s_waitcnt vmcnt(" #N ") lgkmcnt(0)\n\ts_barrier":::"memory")
typedef float f32x4_t __attribute__((ext_vector_type(4)));
typedef const __attribute__((address_space(3))) f32x4_t* lds_f4p;
#define CBIAS(P0,P1,t) do{ lds_f4p cp_=cb4+16*(t)+hi; _Pragma("unroll") for(int g_=0;g_<4;++g_){ const f32x4_t b0_=cp_[2*g_], b1_=cp_[2*g_+8]; P0[4*g_]+=b0_[0];P0[4*g_+1]+=b0_[1];P0[4*g_+2]+=b0_[2];P0[4*g_+3]+=b0_[3]; P1[4*g_]+=b1_[0];P1[4*g_+1]+=b1_[1];P1[4*g_+2]+=b1_[2];P1[4*g_+3]+=b1_[3]; } }while(0)

__device__ __forceinline__ void qkt(f32x16&p0,f32x16&p1,const char*Kslot,const bf16x8*qr,const f32x16&negm,int r32,int hi){
  const char*kb=Kslot+hi*1024+r32*16;
  #pragma unroll
  for(int d0=0;d0<4;++d0){
    const bf16x8 b0=*reinterpret_cast<const bf16x8*>(kb+d0*2048);
    const bf16x8 b1=*reinterpret_cast<const bf16x8*>(kb+d0*2048+512);
    if(d0==0){p0=__builtin_amdgcn_mfma_f32_32x32x16_bf16(b0,qr[0],negm,0,0,0);p1=__builtin_amdgcn_mfma_f32_32x32x16_bf16(b1,qr[0],negm,0,0,0);}
    else{p0=__builtin_amdgcn_mfma_f32_32x32x16_bf16(b0,qr[d0],p0,0,0,0);p1=__builtin_amdgcn_mfma_f32_32x32x16_bf16(b1,qr[d0],p1,0,0,0);}}
}
typedef __attribute__((address_space(3))) const char* lds_cptr;
typedef short v4i16_t __attribute__((ext_vector_type(4)));
__device__ __forceinline__ void kload8(bf16x8*kf,lds_cptr kp){
  kf[0]=*(const __attribute__((address_space(3))) bf16x8*)(kp);      kf[1]=*(const __attribute__((address_space(3))) bf16x8*)(kp+512);
  kf[2]=*(const __attribute__((address_space(3))) bf16x8*)(kp+2048); kf[3]=*(const __attribute__((address_space(3))) bf16x8*)(kp+2560);
  kf[4]=*(const __attribute__((address_space(3))) bf16x8*)(kp+4096); kf[5]=*(const __attribute__((address_space(3))) bf16x8*)(kp+4608);
  kf[6]=*(const __attribute__((address_space(3))) bf16x8*)(kp+6144); kf[7]=*(const __attribute__((address_space(3))) bf16x8*)(kp+6656);
}
__device__ __forceinline__ void kload2(bf16x8*kf,lds_cptr kp,int j){ kf[2*j]=*(const __attribute__((address_space(3))) bf16x8*)(kp+j*2048); kf[2*j+1]=*(const __attribute__((address_space(3))) bf16x8*)(kp+j*2048+512); }
__device__ __forceinline__ s16x4 vtr(lds_cptr p){ return __builtin_bit_cast(s16x4,__builtin_amdgcn_ds_read_tr16_b64_v4i16((__attribute__((address_space(3))) v4i16_t*)p)); }
__device__ __forceinline__ float rowmax(const f32x16&p0,const f32x16&p1){
  float a=max3f(p0[0],p0[1],p1[0]),b=max3f(p0[2],p0[3],p1[1]);a=max3f(a,p1[2],p1[3]);
  #pragma unroll
  for(int r=4;r<16;r+=4){a=max3f(a,p0[r],p0[r+1]);b=max3f(b,p0[r+2],p0[r+3]);a=max3f(a,p1[r],p1[r+1]);b=max3f(b,p1[r+2],p1[r+3]);}
  const float m=max2f(a,b);
  auto rr=__builtin_amdgcn_permlane32_swap(__float_as_uint(m),__float_as_uint(m),false,false);
  return max2f(__uint_as_float(rr[0]),__uint_as_float(rr[1]));
}
__device__ __forceinline__ void pv(f32x16*o,int vb,bf16x8 pa0,bf16x8 pa1,bf16x8 pa2,bf16x8 pa3){
  #pragma unroll
  for(int d0=0;d0<2;++d0){s16x4 lo[4],hi[4];
    #pragma unroll
    for(int ks=0;ks<4;++ks){
      asm volatile("ds_read_b64_tr_b16 %0,%1 offset:%c2":"=&v"(lo[ks]):"v"(vb),"i"(d0*4096+ks*1024):"memory");
      asm volatile("ds_read_b64_tr_b16 %0,%1 offset:%c2":"=&v"(hi[ks]):"v"(vb),"i"(d0*4096+ks*1024+512):"memory");}
    asm volatile("s_waitcnt lgkmcnt(0)":::"memory");SBAR();
    #define PK(k) (bf16x8){lo[k][0],lo[k][1],lo[k][2],lo[k][3],hi[k][0],hi[k][1],hi[k][2],hi[k][3]}
    o[d0]=__builtin_amdgcn_mfma_f32_32x32x16_bf16(pa0,PK(0),o[d0],0,0,0);
    o[d0]=__builtin_amdgcn_mfma_f32_32x32x16_bf16(pa1,PK(1),o[d0],0,0,0);
    o[d0]=__builtin_amdgcn_mfma_f32_32x32x16_bf16(pa2,PK(2),o[d0],0,0,0);
    o[d0]=__builtin_amdgcn_mfma_f32_32x32x16_bf16(pa3,PK(3),o[d0],0,0,0);
    #undef PK
  }
}

#ifndef ATTN_STORE16
#define ATTN_STORE16(p,v) (*(u32x4*)(p)=(v))
#endif
template<int THRL> __device__ __forceinline__ void attn_unit(int b,int h,int qb,const bf16*Q,const bf16*__restrict__ K,const bf16*__restrict__ V,bf16*O,const bf16*__restrict__ G,lds_f4p cb4_in,int T0,char*shm){
  int tid_=threadIdx.x; asm volatile("":"+v"(tid_)); const int tid=tid_,lane=tid&63,r32=lane&31,hi=lane>>5; const int wid=__builtin_amdgcn_readfirstlane(tid>>6);
  const long rowbase=(long)b*SEQ; const int q0=qb*QB; const lds_f4p cb4=cb4_in+16*T0; const __attribute__((address_space(3))) float* cbs=(const __attribute__((address_space(3))) float*)cb4;
  const bf16*Qw=Q+(rowbase+q0+wid*QBLK)*DM+h*D;
  const bf16*Kh=K+(rowbase+(long)T0*KVBLK)*DM+h*D,*Vh=V+(rowbase+(long)T0*KVBLK)*DM+h*D;
  const unsigned lds0=(unsigned)(uintptr_t)shm;
  float*wsf=(float*)(shm+LDS_WS)+wid*64;
  const bf16*ksrc=Kh+(long)lane*DM+wid*8;
  const bf16*vsrc=Vh+(long)(16*(wid&3)+(lane>>2))*DM+(wid>>2)*32+(lane&3)*8;
  const unsigned kdst=lds0+LDS_K+wid*1024, vdst=lds0+LDS_V+wid*1024;
  #define DMA_K(t,slot) glds16(ksrc+(long)(t)*KVBLK*DM,(unsigned)__builtin_amdgcn_readfirstlane(kdst+(slot)))
  #define DMA_V(t,slot) glds16(vsrc+(long)(t)*KVBLK*DM,(unsigned)__builtin_amdgcn_readfirstlane(vdst+(slot)))
  const int vb0=(int)(lds0+LDS_V)+((lane>>4)&1)*32+(lane&3)*8+(4*hi+((lane&15)>>2))*64;
  const char*Kbase=shm+LDS_K; bf16x8 kf[8];
  const lds_cptr shm3=(lds_cptr)shm; const lds_cptr kp0=shm3+LDS_K+hi*1024+r32*16; const lds_cptr vp0=shm3+LDS_V+((lane>>4)&1)*32+(lane&3)*8+(4*hi+((lane&15)>>2))*64;
  const int NT=(q0+QB)/KVBLK-T0;
  DMA_K(0,0);DMA_V(0,0);DMA_K(1,SLOTB);
  bf16x8 qr[4];
  #pragma unroll
  for(int d0=0;d0<4;++d0)qr[d0]=*reinterpret_cast<const bf16x8*>(&Qw[(long)r32*DM+d0*16+hi*8]);
  float mhat=0.f,l_reg=0.f;f32x16 o[2];o[0]=f32x16{};o[1]=f32x16{};f32x16 negm=f32x16{};asm volatile("":"+v"(negm));
  const int qrel=wid*QBLK+r32;
  #define CMASK(P0,P1,t) do{int jb_=(t)-(NT-4); if(jb_>=0)cmask(P0,P1,jb_,qrel,hi);}while(0)
  bool resc=false;
  #define START(P0,P1) do{ const float rm=rowmax(P0,P1); resc=false; \
    { const float dl=rm; mhat=fadd_s(mhat,dl); \
      _Pragma("unroll") for(int r=0;r<16;++r){P0[r]=fsub_s(P0[r],dl);P1[r]=fsub_s(P1[r],dl);} \
      _Pragma("unroll") for(int r=0;r<16;++r)negm[r]=-mhat; asm volatile("":"+v"(negm)); } \
    _Pragma("unroll") for(int r=0;r<16;++r)P0[r]=__builtin_amdgcn_exp2f(P0[r]); }while(0)
  #define RESC() do{ if(resc){ asm volatile("s_waitcnt lgkmcnt(0)":::"memory"); \
      _Pragma("unroll") for(int d_=0;d_<2;++d_) _Pragma("unroll") for(int r=0;r<16;++r)o[d_][r]*=wsf[crow(r,hi)]; } }while(0)
  f32x16 pA0,pA1,pB0,pB1;
  int sl_prev=0,sl_cur=0,sl_next=SLOTB;
  #define ROT() do{sl_prev=sl_cur;sl_cur=sl_next;sl_next=(sl_next==(NSLOT-1)*SLOTB)?0:sl_next+SLOTB;}while(0)
  DMA_K(2,2*SLOTB);
  WAIT_BAR(3);
  qkt(pA0,pA1,Kbase,qr,negm,r32,hi);asm volatile("s_nop 15\n\ts_nop 7":"+v"(pA0),"+v"(pA1));CBIAS(pA0,pA1,0);CMASK(pA0,pA1,0);
  START(pA0,pA1);
  _Pragma("unroll") for(int r=0;r<16;++r)pA1[r]=__builtin_amdgcn_exp2f(pA1[r]);
  WAIT_BAR(0);
  DMA_K(3,0);DMA_V(1,SLOTB);
  ROT();
  kload8(kf,kp0+sl_cur);
  WAIT_BAR(2);
  s16x4 vlo[8],vhi[8]; u32x4 pw0,pw1,pw2,pw3;
  #define PKW(P,B) cvtpk_s(P[B],P[B+1])
  #define PAF(k) __builtin_bit_cast(bf16x8,pw##k)
  #define VFR(i) (bf16x8){vlo[i][0],vlo[i][1],vlo[i][2],vlo[i][3],vhi[i][0],vhi[i][1],vhi[i][2],vhi[i][3]}
  #define PIN(x) asm volatile("":"+v"(x))
  #define MX3(a,b,c) __builtin_fmaxf(__builtin_fmaxf((a),(b)),(c))
  #define GAPA(MF,A0,A1,A2,A3,W0,W1,PW) do{ MF; sacc+=A0; sacc+=A1; sacc+=A2; sacc+=A3; PIN(sacc); W0; W1; PIN(PW); SBAR(); }while(0)
  #define EX(v) __builtin_amdgcn_exp2f(v)
  #define GAPB(MF,X,B,NI) do{ const f32x4_t bc_=bnx_; bnx_=cp_[NI]; MF; X[B]=EX(X[B]+bc_[0]); X[B+1]=EX(X[B+1]+bc_[1]); X[B+2]=EX(X[B+2]+bc_[2]); X[B+3]=EX(X[B+3]+bc_[3]); PIN(X); SBAR(); }while(0)
  #define VRD(i) do{ vlo[i]=vtr(vp_+(((i)>>2)*4096+((i)&3)*1024)); vhi[i]=vtr(vp_+(((i)>>2)*4096+((i)&3)*1024+512)); }while(0)
  #define KRD(G,j) do{ if(G){ kload2(kf,kp0+sl_next,j); SBAR(); } }while(0)
  #define STEP(C0,C1,P0,P1,t,GK,GV,GL) do{ SBAR(); \
    const lds_cptr vp_=vp0+sl_prev; \
    VRD(0); SBAR(); float sacc=(P0[0]+P0[1]); \
    GAPA(C0=__builtin_amdgcn_mfma_f32_32x32x16_bf16(kf[0],qr[0],negm,0,0,0), P0[2],P0[3],P0[4],P0[5],     pw0[0]=PKW(P0,0), pw0[1]=PKW(P0,2), pw0); \
    VRD(4); SBAR(); GAPA(C1=__builtin_amdgcn_mfma_f32_32x32x16_bf16(kf[1],qr[0],negm,0,0,0), P0[6],P0[7],P0[8],P0[9],     pw0[2]=PKW(P0,4), pw0[3]=PKW(P0,6), pw0); \
    VRD(1); SBAR(); GAPA(C0=__builtin_amdgcn_mfma_f32_32x32x16_bf16(kf[2],qr[1],C0,0,0,0),   P0[10],P0[11],P0[12],P0[13], pw1[0]=PKW(P0,8), pw1[1]=PKW(P0,10), pw1); \
    VRD(5); SBAR(); GAPA(C1=__builtin_amdgcn_mfma_f32_32x32x16_bf16(kf[3],qr[1],C1,0,0,0),   P0[14],P0[15],P1[0],P1[1],   pw1[2]=PKW(P0,12),pw1[3]=PKW(P0,14), pw1); \
    VRD(2); SBAR(); GAPA(C0=__builtin_amdgcn_mfma_f32_32x32x16_bf16(kf[4],qr[2],C0,0,0,0),   P1[2],P1[3],P1[4],P1[5],     pw2[0]=PKW(P1,0), pw2[1]=PKW(P1,2), pw2); \
    VRD(6); SBAR(); GAPA(C1=__builtin_amdgcn_mfma_f32_32x32x16_bf16(kf[5],qr[2],C1,0,0,0),   P1[6],P1[7],P1[8],P1[9],     pw2[2]=PKW(P1,4), pw2[3]=PKW(P1,6), pw2); \
    VRD(3); SBAR(); GAPA(C0=__builtin_amdgcn_mfma_f32_32x32x16_bf16(kf[6],qr[3],C0,0,0,0),   P1[10],P1[11],P1[12],P1[13], pw3[0]=PKW(P1,8), pw3[1]=PKW(P1,10), pw3); \
    VRD(7); SBAR(); GAPA(C1=__builtin_amdgcn_mfma_f32_32x32x16_bf16(kf[7],qr[3],C1,0,0,0),   P1[14],P1[15],0.f,0.f,       pw3[2]=PKW(P1,12),pw3[3]=PKW(P1,14), pw3); \
    l_reg+=sacc; \
    if(GK){DMA_K((t)+3,sl_cur);} if(GV){DMA_V((t)+1,sl_next);} \
    CMASK(C0,C1,t); \
    { float a=MX3(C0[0],C0[1],C1[0]),b=MX3(C0[2],C0[3],C1[1]); a=MX3(a,C1[2],C1[3]); \
      _Pragma("unroll") for(int r=4;r<16;r+=4){a=MX3(a,C0[r],C0[r+1]);b=MX3(b,C0[r+2],C0[r+3]);a=MX3(a,C1[r],C1[r+1]);b=MX3(b,C1[r+2],C1[r+3]);} \
      float rm=__builtin_fmaxf(a,b); { auto rr=__builtin_amdgcn_permlane32_swap(__float_as_uint(rm),__float_as_uint(rm),false,false); rm=__builtin_fmaxf(__uint_as_float(rr[0]),__uint_as_float(rr[1])); } \
      rm+=cbs[64*(t)+63]; resc=false; \
      if(__builtin_expect(__any(rm>(float)THRL),0)){ const float dl=__builtin_fmaxf(rm,0.f); mhat+=dl; \
        _Pragma("unroll") for(int r=0;r<16;++r){C0[r]-=dl;C1[r]-=dl;} \
        _Pragma("unroll") for(int r=0;r<16;++r)negm[r]=-mhat; asm volatile("":"+v"(negm)); \
        const float f=__builtin_amdgcn_exp2f(-dl); l_reg*=f; if(hi==0)wsf[r32]=f; resc=true; } } \
    lds_f4p cp_=cb4+16*(t)+hi; f32x4_t bnx_=cp_[0]; SBAR(); \
    GAPB(o[0]=__builtin_amdgcn_mfma_f32_32x32x16_bf16(PAF(0),VFR(0),o[0],0,0,0), C0,0,2); \
    GAPB(o[1]=__builtin_amdgcn_mfma_f32_32x32x16_bf16(PAF(0),VFR(4),o[1],0,0,0), C0,4,4); \
    KRD(GL,0); GAPB(o[0]=__builtin_amdgcn_mfma_f32_32x32x16_bf16(PAF(1),VFR(1),o[0],0,0,0), C0,8,6); \
    KRD(GL,1); GAPB(o[1]=__builtin_amdgcn_mfma_f32_32x32x16_bf16(PAF(1),VFR(5),o[1],0,0,0), C0,12,8); \
    KRD(GL,2); GAPB(o[0]=__builtin_amdgcn_mfma_f32_32x32x16_bf16(PAF(2),VFR(2),o[0],0,0,0), C1,0,10); \
    KRD(GL,3); GAPB(o[1]=__builtin_amdgcn_mfma_f32_32x32x16_bf16(PAF(2),VFR(6),o[1],0,0,0), C1,4,12); \
    GAPB(o[0]=__builtin_amdgcn_mfma_f32_32x32x16_bf16(PAF(3),VFR(3),o[0],0,0,0), C1,8,14); \
    GAPB(o[1]=__builtin_amdgcn_mfma_f32_32x32x16_bf16(PAF(3),VFR(7),o[1],0,0,0), C1,12,14); \
    }while(0)
  int t=1;
  #undef CMASK
  #define CMASK(P0,P1,t) do{}while(0)
  for(;t+5<NT;t+=2){
    STEP(pB0,pB1,pA0,pA1,t,true,true,true);     WAIT_BAR(2); RESC(); ROT();
    STEP(pA0,pA1,pB0,pB1,t+1,true,true,true);   WAIT_BAR(2); RESC(); ROT();
  }
  #undef CMASK
  #define CMASK(P0,P1,t) do{int jb_=(t)-(NT-4); if(jb_>=0)cmask(P0,P1,jb_,qrel,hi);}while(0)
  #define ENDW(tt) do{ if((tt)+3<NT){WAIT_BAR(2);} else if((tt)+2<NT){WAIT_BAR(1);} else {WAIT_BAR(0);} }while(0)
  for(;t+1<NT;t+=2){
    STEP(pB0,pB1,pA0,pA1,t,(t+3<NT),(t+1<NT),(t+1<NT));       ENDW(t);   RESC(); ROT();
    STEP(pA0,pA1,pB0,pB1,t+1,(t+4<NT),(t+2<NT),(t+2<NT));     ENDW(t+1); RESC(); ROT();
  }
  STEP(pB0,pB1,pA0,pA1,NT-1,false,false,false); RESC();
  { float sacc=pB0[0]+pB0[1]; _Pragma("unroll") for(int r=2;r<16;++r)sacc+=pB0[r]; _Pragma("unroll") for(int r=0;r<16;++r)sacc+=pB1[r]; l_reg+=sacc;
    pw0=(u32x4){PKW(pB0,0),PKW(pB0,2),PKW(pB0,4),PKW(pB0,6)};pw1=(u32x4){PKW(pB0,8),PKW(pB0,10),PKW(pB0,12),PKW(pB0,14)};pw2=(u32x4){PKW(pB1,0),PKW(pB1,2),PKW(pB1,4),PKW(pB1,6)};pw3=(u32x4){PKW(pB1,8),PKW(pB1,10),PKW(pB1,12),PKW(pB1,14)};
    SBAR(); pv(o,vb0+sl_cur,PAF(0),PAF(1),PAF(2),PAF(3)); }
  #undef PKW
  #undef PAF
  #undef VFR
  #undef PIN
  #undef MX3
  #undef GAPA
  #undef GAPB
  #undef EX
  #undef VRD
  #undef KRD
  #undef STEP
  #undef ENDW
  {auto rr=__builtin_amdgcn_permlane32_swap(__float_as_uint(l_reg),__float_as_uint(l_reg),false,false);l_reg=__uint_as_float(rr[0])+__uint_as_float(rr[1]);}
  if(hi==0)wsf[32+r32]=l_reg;asm volatile("s_waitcnt lgkmcnt(0)":::"memory");
  float rli[16];
  #pragma unroll
  for(int r=0;r<16;++r)rli[r]=__builtin_amdgcn_rcpf(wsf[32+crow(r,hi)]);
  bf16*Ow=O+(rowbase+q0+wid*QBLK)*OPITCH+h*D; const bf16*Gw=G+(rowbase+q0+wid*QBLK)*DM+h*D;
  { bf16*stg=(bf16*)(shm+LDS_OST)+wid*2048;
    #pragma unroll
    for(int r=0;r<16;++r){const int orow=crow(r,hi);
      #pragma unroll
      for(int d0=0;d0<2;++d0)stg[orow*64+d0*32+r32]=__float2bfloat16(o[d0][r]*rli[r]);}
    asm volatile("s_waitcnt lgkmcnt(0)":::"memory");
    #pragma unroll
    for(int i=0;i<4;++i){const int row=i*8+(lane>>3),ch=lane&7; u32x4 v=*(const u32x4*)(stg+row*64+ch*8); const u32x4 gg=*(const u32x4*)(Gw+(long)row*DM+ch*8);
      _Pragma("unroll") for(int e_=0;e_<4;++e_){ const float a0=__uint_as_float(v[e_]<<16)*__uint_as_float(gg[e_]<<16), a1=__uint_as_float(v[e_]&0xffff0000u)*__uint_as_float(gg[e_]&0xffff0000u); v[e_]=cvtpk_s(a0,a1); }
      ATTN_STORE16(Ow+(long)row*OPITCH+ch*8,v);} }
  asm volatile("s_waitcnt lgkmcnt(0)\n\ts_barrier":::"memory");
  #undef DMA_K
  #undef DMA_V
  #undef CMASK
  #undef START
  #undef RESC
  #undef ROT
}
constexpr int ATTN_LDS_BYTES=LDS_BYTES;
#undef SBAR
#undef WAIT_BAR
}
#define LAS __attribute__((address_space(3)))
typedef unsigned short bf16;
typedef unsigned v4u __attribute__((ext_vector_type(4)));
typedef unsigned v2u __attribute__((ext_vector_type(2)));
typedef float f32x4 __attribute__((ext_vector_type(4)));
typedef short bf16x8 __attribute__((ext_vector_type(8)));
typedef short s16x4 __attribute__((ext_vector_type(4)));
using pg8::bf_lo; using pg8::bf_hi;
constexpr int NWAVES = 8, NTHR = 512;
constexpr int BATCH = 4, SEQ = 4096, DM = 2048, T = BATCH * SEQ, DEPTH = 2, MEMLEN = 256, MROWS = BATCH * MEMLEN;
constexpr int INC = 12312, NZ = 12544, ZP = 12288;
constexpr int ZC_GQ = 0, ZC_GK = 512, ZC_GV = 1024, ZC_GG = 2048, ZC_FQ = 3072, ZC_FK = 3584, ZC_FV = 4096, ZC_FG = 4608, ZC_MQ = 5120, ZC_MG = 5632, ZC_MERGE = 6144;
constexpr size_t MiB = 1u << 20;
constexpr size_t WS_WIN = 0, WS_WBR = 98 * MiB, WS_WOUT = 114 * MiB, WS_WKV = 130 * MiB, WS_XB = 138 * MiB, WS_Y = 202 * MiB, WS_U = 266 * MiB, WS_Z = 330 * MiB,
                 WS_ZS = 714 * MiB, WS_MEMB = 716 * MiB, WS_MKV = 720 * MiB, WS_DV = 724 * MiB, WS_SS = 725 * MiB, WS_CTL = 726 * MiB, WS_FOXT = 727 * MiB, WS_END = 728 * MiB;
constexpr int FT_CBL = 0, FT_SEG = 32 * 4096, FT_QNB = FT_SEG + 32 * 8, FT_KNS = FT_QNB + 32 * 16;
constexpr size_t CTL_ZERO_BYTES = 65536;
constexpr int LDS_BYTES = 155648;

typedef float f32x2c_t __attribute__((ext_vector_type(2))); typedef __bf16 bf16x2c_t __attribute__((ext_vector_type(2)));
__device__ __forceinline__ unsigned pk2(float lo, float hi) { const f32x2c_t v = {lo, hi}; return __builtin_bit_cast(unsigned, __builtin_convertvector(v, bf16x2c_t)); }
__device__ __forceinline__ unsigned f2bf(float f) { return pk2(f, 0.f) & 0xffffu; }
__device__ __forceinline__ float bf2f(bf16 v) { return __uint_as_float(((unsigned)v) << 16); }
__device__ __forceinline__ float wave_sum(float v) {
#pragma unroll
    for (int o = 1; o < 64; o <<= 1) v += __shfl_xor(v, o);
    return v;
}
__device__ __forceinline__ float logsig(float x) { return fminf(x, 0.f) - __logf(1.f + __expf(-fabsf(x))); }
#define DPP_ADD(v, ctrl) ((v) + __builtin_bit_cast(float, __builtin_amdgcn_update_dpp(0, __builtin_bit_cast(int, (v)), (ctrl), 0xF, 0xF, true)))
__device__ __forceinline__ float row16_sum(float v) { v = DPP_ADD(v, 0xB1); v = DPP_ADD(v, 0x4E); v = DPP_ADD(v, 0x141); v = DPP_ADD(v, 0x140); return v; }
#define MFMA16(a, b, c) __builtin_amdgcn_mfma_f32_16x16x32_bf16((a), (b), (c), 0, 0, 0)
__device__ __forceinline__ s16x4 trread(const LAS unsigned char* p) { return __builtin_bit_cast(s16x4, __builtin_amdgcn_ds_read_tr16_b64_v4i16((LAS s16x4*)p)); }
__device__ __forceinline__ bf16x8 cat8(s16x4 lo, s16x4 hi) { return (bf16x8){lo[0], lo[1], lo[2], lo[3], hi[0], hi[1], hi[2], hi[3]}; }

#define GAS __attribute__((address_space(1)))
#define XB_TMO      128
#define XB_XCNT(j)  (256  + 64 * (j))
#define XB_XSUB(j)  (1280 + 64 * (j))
#define XB_XGEN(j)  (2304 + 64 * (j))
#define XB_TOP      3328
#define XB_TOPGEN   3392
#define XCD_BAR_WORDS 3456
#define XB_SPIN_CAP (1u << 18)

__device__ __forceinline__ unsigned xb_ld(unsigned* p)              { return __hip_atomic_load(p, __ATOMIC_RELAXED, __HIP_MEMORY_SCOPE_AGENT); }
__device__ __forceinline__ unsigned xb_add(unsigned* p, unsigned v) { return __hip_atomic_fetch_add(p, v, __ATOMIC_RELAXED, __HIP_MEMORY_SCOPE_AGENT); }
__device__ __forceinline__ unsigned xb_xcc_id() { return (unsigned)__builtin_amdgcn_s_getreg((3 << 11) | 20) & 0xFu; }
#define XB_SPIN(cond, bar) do { unsigned _sp = 0; while (cond) { __builtin_amdgcn_s_sleep(1); \
    if ((++_sp & 255u) == 0u) { if (xb_ld(&(bar)[XB_TMO])) break; if (_sp > XB_SPIN_CAP) { atomicAdd(&(bar)[XB_TMO], 1u); break; } } } } while (0)

struct XcdBarrier {
    unsigned* bar; unsigned x;
    volatile LAS unsigned* st;
};

__device__ __forceinline__ XcdBarrier xcd_barrier_post(unsigned* bar, volatile LAS unsigned* st) {
    XcdBarrier b; b.bar = bar; b.x = xb_xcc_id(); b.st = st;
    if (threadIdx.x == 0) (void)xb_add(&bar[XB_XCNT(b.x)], 1u);
    return b;
}
__device__ __forceinline__ void xcd_barrier_complete(unsigned* bar, unsigned x, unsigned& nloc, unsigned& nx) {
    const unsigned G = gridDim.x * gridDim.y * gridDim.z;
    unsigned sum, cnt, mine, sp = 0u;
    for (;;) {
        sum = 0u; cnt = 0u; mine = 0u;
#pragma unroll
        for (unsigned j = 0; j < 16; ++j) { const unsigned c = xb_ld(&bar[XB_XCNT(j)]); sum += c; cnt += (c > 0u) ? 1u : 0u; mine = (j == x) ? c : mine; }
        if (sum == G) break;
        __builtin_amdgcn_s_sleep(1);
        if ((++sp & 255u) == 0u) { if (xb_ld(&bar[XB_TMO])) break; if (sp > XB_SPIN_CAP) { atomicAdd(&bar[XB_TMO], 1u); break; } }
    }
    nloc = mine > 0u ? mine : 1u; nx = cnt > 0u ? cnt : 1u;
}

__device__ __forceinline__ void xcd_barrier(const XcdBarrier& b) {
    asm volatile("s_waitcnt vmcnt(0)" ::: "memory");
    __syncthreads();
    if (threadIdx.x == 0) {
        unsigned* bar = b.bar; asm volatile("" : "+s"(bar));
        const unsigned bx_ = xb_xcc_id();
        __builtin_amdgcn_s_waitcnt(0);
        unsigned nloc = b.st[0], nx = b.st[1];
        if (nloc == 0u) { xcd_barrier_complete(bar, bx_, nloc, nx); b.st[0] = nloc; b.st[1] = nx; }
        const unsigned old = xb_add(&bar[XB_XSUB(bx_)], 1u);
        const unsigned gen = old / nloc;
        if (old + 1u == (gen + 1u) * nloc) {
            __builtin_amdgcn_fence(__ATOMIC_RELEASE, "agent");
            asm volatile("s_waitcnt vmcnt(0)" ::: "memory");
            const unsigned og = xb_add(&bar[XB_TOP], 1u);
            const unsigned tg = og / nx;
            if (og + 1u == (tg + 1u) * nx) xb_add(&bar[XB_TOPGEN], 1u);
            else XB_SPIN(xb_ld(&bar[XB_TOPGEN]) == tg, bar);
            __builtin_amdgcn_fence(__ATOMIC_ACQUIRE, "agent");
            xb_add(&bar[XB_XGEN(bx_)], 1u);
            asm volatile("s_waitcnt vmcnt(0)" ::: "memory");
        } else {
            XB_SPIN(xb_ld(&bar[XB_XGEN(bx_)]) == gen, bar);
            __builtin_amdgcn_fence(__ATOMIC_ACQUIRE, "agent");
            asm volatile("s_waitcnt vmcnt(0)" ::: "memory");
        }
    }
    __syncthreads();
}


struct Params {
    const float *x, *mem, *norm_gain, *w_in, *w_gk_up, *b_gk, *gla_norm_gain, *b_f, *mem_norm_gain, *w_mem_kv, *w_branch, *w_out, *final_gain;
    float* out; unsigned char* ws;
};

__device__ __forceinline__ int win_src_col(int n) {
    if (n < 3072) return n;
    if (n < 4608) return n + 16;
    if (n < 12288) return n + 24;
    if (n < 12304) return 3072 + (n - 12288);
    if (n < 12312) return 4624 + (n - 12304);
    return -1;
}
__device__ __forceinline__ void transpose_item(const float* W, int Nsrc, const float* gain, int kind, bf16* WT, int item, int nblk, int lane) {
    const int kb = item / nblk, nb = item % nblk, k0 = 64 * kb, nn = 64 * nb + lane;
    const int sc = kind == 0 ? win_src_col(nn) : nn;
    const float* src = W + (size_t)k0 * Nsrc + (sc >= 0 ? sc : 0);
    float v[64];
#pragma unroll
    for (int kk = 0; kk < 64; ++kk) v[kk] = src[(size_t)kk * Nsrc];
    if (gain) {
#pragma unroll
        for (int q = 0; q < 16; ++q) { const f32x4 g = *(const f32x4*)(gain + k0 + 4 * q); v[4 * q] *= g[0]; v[4 * q + 1] *= g[1]; v[4 * q + 2] *= g[2]; v[4 * q + 3] *= g[3]; } }
    if (sc < 0) {
#pragma unroll
        for (int kk = 0; kk < 64; ++kk) v[kk] = 0.f; }
    bf16* dst = WT + (size_t)nn * 2048 + k0;
#pragma unroll
    for (int c = 0; c < 8; ++c) { v4u o; o.x = pk2(v[8 * c], v[8 * c + 1]); o.y = pk2(v[8 * c + 2], v[8 * c + 3]); o.z = pk2(v[8 * c + 4], v[8 * c + 5]); o.w = pk2(v[8 * c + 6], v[8 * c + 7]); *(v4u*)(dst + 8 * c) = o; }
}
__device__ __forceinline__ void row_to_bf16(const float* xrow, bf16* orow, int lane) {
    const f32x4* xr = (const f32x4*)xrow + lane; float s = 0.f; v2u* o8 = (v2u*)orow + lane; f32x4 v[8];
#pragma unroll
    for (int j = 0; j < 8; ++j) { v[j] = xr[64 * j]; s += (v[j].x * v[j].x + v[j].y * v[j].y) + (v[j].z * v[j].z + v[j].w * v[j].w); }
    const float r = rsqrtf(wave_sum(s) * (1.0f / 2048.0f) + 1e-6f);
#pragma unroll
    for (int j = 0; j < 8; ++j) { v2u w; w.x = pk2(v[j].x * r, v[j].y * r); w.y = pk2(v[j].z * r, v[j].w * r); o8[64 * j] = w; }
}
__device__ __forceinline__ void rescale_rows(bf16* xb, const float* ssq, int tid, int G) {
    const int lane = tid & 63, wave = tid >> 6;
    for (int m = blockIdx.x * NWAVES + wave; m < T; m += G * NWAVES) { const float r = rsqrtf(ssq[m] * (1.0f / 2048.0f) + 1e-6f); v2u* o8 = (v2u*)(xb + (size_t)m * DM) + lane;
#pragma unroll
        for (int j = 0; j < 8; ++j) { v2u w = o8[64 * j]; w.x = pk2(bf_lo(w.x) * r, bf_hi(w.x) * r); w.y = pk2(bf_lo(w.y) * r, bf_hi(w.y) * r); o8[64 * j] = w; } }
}
__device__ __forceinline__ void phase_prologue(const Params& P, LAS unsigned char* lds, int tid, int G) {
    const int lane = tid & 63, wave = tid >> 6; const int gw = blockIdx.x * NWAVES + wave, NGW = G * NWAVES;
    unsigned char* ws = P.ws;
    constexpr int I_IN = 32 * (NZ / 64), I_BR = 32 * 32, I_OUT = 32 * 32, I_KV = 32 * 16, I_L = I_IN + I_BR + I_OUT + I_KV;
    for (int it = gw; it < DEPTH * I_L; it += NGW) {
        const int l = it / I_L; int r = it % I_L;
        if (r < I_IN) { transpose_item(P.w_in + (size_t)l * 2048 * INC, INC, P.norm_gain + l * 2048, 0, (bf16*)(ws + WS_WIN) + (size_t)l * NZ * 2048, r, NZ / 64, lane); continue; } r -= I_IN;
        if (r < I_BR) { transpose_item(P.w_branch + (size_t)l * 2048 * 2048, 2048, nullptr, 1, (bf16*)(ws + WS_WBR) + (size_t)l * 2048 * 2048, r, 32, lane); continue; } r -= I_BR;
        if (r < I_OUT) { transpose_item(P.w_out + (size_t)l * 2048 * 2048, 2048, nullptr, 1, (bf16*)(ws + WS_WOUT) + (size_t)l * 2048 * 2048, r, 32, lane); continue; } r -= I_OUT;
        transpose_item(P.w_mem_kv + (size_t)l * 2048 * 1024, 1024, P.mem_norm_gain + l * 2048, 1, (bf16*)(ws + WS_WKV) + (size_t)l * 1024 * 2048, r, 16, lane);
    }
    float* ss = (float*)(ws + WS_SS);
    for (int m = gw; m < T; m += NGW) row_to_bf16(P.x + (size_t)m * DM, (bf16*)(ws + WS_XB) + (size_t)m * DM, lane);
    for (int m = gw; m < MROWS; m += NGW) row_to_bf16(P.mem + (size_t)m * DM, (bf16*)(ws + WS_MEMB) + (size_t)m * DM, lane);
    for (int i = blockIdx.x * NTHR + tid; i < 2 * T; i += G * NTHR) ss[T + i] = 0.f;
}
__device__ __forceinline__ void gla_decay(LAS float* gd, LAS float* tot, int tid, const float (&w)[16], float bias, float (&bv)[16], float& blast) {
    const int d = tid & 127, rg = tid >> 7;
    float run = 0.f;
#pragma unroll
    for (int c = 0; c < 16; ++c) { const LAS f32x4* g4 = (const LAS f32x4*)(gd + (rg * 16 + c) * 16); float a = bias;
#pragma unroll
        for (int q = 0; q < 4; ++q) { const f32x4 g = g4[q]; a += g[0] * w[4 * q] + g[1] * w[4 * q + 1] + g[2] * w[4 * q + 2] + g[3] * w[4 * q + 3]; }
        run += logsig(a) * 0.0625f; bv[c] = run; }
    tot[rg * 128 + d] = run;
    __syncthreads();
    const float t0 = tot[d], t1 = tot[128 + d], t2 = tot[256 + d], t3 = tot[384 + d];
    const float off = (rg > 0 ? t0 : 0.f) + (rg > 1 ? t1 : 0.f) + (rg > 2 ? t2 : 0.f);
    blast = (t0 + t1) + (t2 + t3);
#pragma unroll
    for (int c = 0; c < 16; ++c) bv[c] += off;
}
__device__ __forceinline__ void load_v(const bf16* src, int tid, v4u (&r)[4]) {
#pragma unroll
    for (int i = 0; i < 4; ++i) { const int idx = tid + 512 * i, row = idx >> 5, ch = idx & 31; r[i] = *(const v4u*)(src + (size_t)row * ZP + ch * 8); }
}
__device__ __forceinline__ void store_v(LAS unsigned char* vt, int tid, const v4u (&r)[4]) {
#pragma unroll
    for (int i = 0; i < 4; ++i) { const int idx = tid + 512 * i, row = idx >> 5, ch = idx & 31; *(LAS v4u*)(vt + row * 544 + ch * 16) = r[i]; }
}
struct G1Pre { v4u vr[4]; };
__device__ __forceinline__ void gla_step1_pre(const Params& P, int item, int tid, G1Pre& R) {
    const int bh = item >> 6, n = item & 63, b = bh >> 2, h = bh & 3; const int t0 = b * SEQ + n * 64; const bf16* z = (const bf16*)(P.ws + WS_Z);
    load_v(z + (size_t)t0 * ZP + ZC_GV + h * 256, tid, R.vr);
}
__device__ __forceinline__ void gla_step1(const Params& P, int l, LAS unsigned char* lds, int item, int next_item, int tid, G1Pre& R) {
    const int bh = item >> 6, n = item & 63, b = bh >> 2, h = bh & 3; const int t0 = b * SEQ + n * 64;
    const bf16* z = (const bf16*)(P.ws + WS_Z); const float* zs = (const float*)(P.ws + WS_ZS);
    LAS unsigned char* KD = lds; LAS unsigned char* VT = lds + 18432; LAS float* GD = (LAS float*)(lds + 53248); LAS float* TOT = (LAS float*)(lds + 57344);
    const int d = tid & 127, rg = tid >> 7;
    f32x4 gdr = (f32x4){0.f, 0.f, 0.f, 0.f}; if (tid < 256) gdr = *(const f32x4*)(zs + (size_t)t0 * 32 + (tid >> 2) * 32 + (tid & 3) * 4);
    float wv[16]; { const float* wup = P.w_gk_up + (size_t)l * 16 * 512 + h * 128;
#pragma unroll
      for (int r = 0; r < 16; ++r) wv[r] = wup[r * 512 + d]; }
    const float bias = P.b_gk[l * 512 + h * 128 + d];
    bf16 kraw[16];
#pragma unroll
    for (int c = 0; c < 16; ++c) kraw[c] = z[(size_t)(t0 + rg * 16 + c) * ZP + ZC_GK + h * 128 + d];
    __syncthreads();
    if (tid < 256) *(LAS f32x4*)(GD + (tid >> 2) * 16 + (tid & 3) * 4) = gdr;
    store_v(VT, tid, R.vr);
    __syncthreads();
    float bv[16], blast;
    gla_decay(GD, TOT, tid, wv, bias, bv, blast);
    { unsigned pk[8];
#pragma unroll
      for (int c = 0; c < 16; c += 2) { const float k0 = bf2f(kraw[c]) * __expf(blast - bv[c]), k1 = bf2f(kraw[c + 1]) * __expf(blast - bv[c + 1]); pk[c >> 1] = pk2(k0, k1); }
      *(LAS v4u*)(KD + d * 144 + rg * 32) = (v4u){pk[0], pk[1], pk[2], pk[3]}; *(LAS v4u*)(KD + d * 144 + rg * 32 + 16) = (v4u){pk[4], pk[5], pk[6], pk[7]}; }
    if (rg == 0) ((float*)(P.ws + WS_DV))[(size_t)item * 128 + d] = __expf(blast);
    if (next_item >= 0) gla_step1_pre(P, next_item, tid, R);
    __syncthreads();
    const int lane = tid & 63, w = tid >> 6, i = lane & 15, quad = lane >> 4; const int e0 = w * 32;
    bf16x8 vf[2][2];
#pragma unroll
    for (int et = 0; et < 2; ++et)
#pragma unroll
        for (int ks = 0; ks < 2; ++ks) { const LAS unsigned char* p = VT + (ks * 32 + quad * 8 + (i >> 2)) * 544 + (e0 + et * 16 + 4 * (i & 3)) * 2; vf[et][ks] = cat8(trread(p), trread(p + 4 * 544)); }
    f32x4 acc[8][2];
#pragma unroll
    for (int dt = 0; dt < 8; ++dt) { acc[dt][0] = (f32x4){0.f, 0.f, 0.f, 0.f}; acc[dt][1] = (f32x4){0.f, 0.f, 0.f, 0.f};
#pragma unroll
        for (int ks = 0; ks < 2; ++ks) { const bf16x8 kf = *(const LAS bf16x8*)(KD + (dt * 16 + i) * 144 + (ks * 32 + quad * 8) * 2);
            acc[dt][0] = MFMA16(kf, vf[0][ks], acc[dt][0]); acc[dt][1] = MFMA16(kf, vf[1][ks], acc[dt][1]); } }
    bf16* Ut = (bf16*)(P.ws + WS_U) + (size_t)item * 256 * 128;
#pragma unroll
    for (int dt = 0; dt < 8; ++dt)
#pragma unroll
        for (int et = 0; et < 2; ++et) { const f32x4 a = acc[dt][et]; v2u o; o.x = pk2(a[0], a[1]); o.y = pk2(a[2], a[3]);
            *(v2u*)(Ut + (size_t)(e0 + et * 16 + i) * 128 + dt * 16 + quad * 4) = o; }
}
__device__ __forceinline__ void gla_scan(const Params& P, int tid, int cu, int ncu) {
    const bf16* Ut = (const bf16*)(P.ws + WS_U); bf16* St = (bf16*)(P.ws + WS_Y); const float* dv = (const float*)(P.ws + WS_DV);
    const int NW = 16 * 8192, half = NW / 2;
    for (int wk = cu * NTHR + tid; wk < half; wk += ncu * NTHR) {
        const int wa = wk, wb = wk + half;
        const int bha = wa >> 13, pa = wa & 8191, bhb = wb >> 13, pb = wb & 8191; const int da = (pa & 31) * 4, db = (pb & 31) * 4;
        float a0 = 0.f, a1 = 0.f, a2 = 0.f, a3 = 0.f, b0 = 0.f, b1 = 0.f, b2 = 0.f, b3 = 0.f;
        const size_t basea = (size_t)bha * 64 * 32768 + (size_t)pa * 4, baseb = (size_t)bhb * 64 * 32768 + (size_t)pb * 4;
#pragma unroll 8
        for (int n = 0; n < 64; ++n) {
            const v2u ua = *(const v2u*)(Ut + basea + (size_t)n * 32768), ub = *(const v2u*)(Ut + baseb + (size_t)n * 32768);
            const f32x4 dda = *(const f32x4*)(dv + (size_t)(bha * 64 + n) * 128 + da), ddb = *(const f32x4*)(dv + (size_t)(bhb * 64 + n) * 128 + db);
            v2u oa, ob; oa.x = pk2(a0, a1); oa.y = pk2(a2, a3); ob.x = pk2(b0, b1); ob.y = pk2(b2, b3);
            *(v2u*)(St + basea + (size_t)n * 32768) = oa; *(v2u*)(St + baseb + (size_t)n * 32768) = ob;
            a0 = a0 * dda[0] + bf_lo(ua.x); a1 = a1 * dda[1] + bf_hi(ua.x); a2 = a2 * dda[2] + bf_lo(ua.y); a3 = a3 * dda[3] + bf_hi(ua.y);
            b0 = b0 * ddb[0] + bf_lo(ub.x); b1 = b1 * ddb[1] + bf_hi(ub.x); b2 = b2 * ddb[2] + bf_lo(ub.y); b3 = b3 * ddb[3] + bf_hi(ub.y);
        }
    }
}
__device__ __forceinline__ void gla_step3(const Params& P, int l, LAS unsigned char* lds, int item, int tid) {
    const int bh = item >> 6, n = item & 63, b = bh >> 2, h = bh & 3; const int t0 = b * SEQ + n * 64;
    const bf16* z = (const bf16*)(P.ws + WS_Z); const float* zs = (const float*)(P.ws + WS_ZS);
    LAS unsigned char* QT = lds; LAS unsigned char* KT = lds + 17408; LAS unsigned char* VT = lds + 34816; LAS unsigned char* ST = lds + 69632; LAS unsigned char* PL = lds + 139264;
    LAS float* GD = (LAS float*)(lds + 139264); LAS float* TOT = (LAS float*)(lds + 139264 + 4096); LAS float* PART = (LAS float*)(lds + 148480);
    const int d = tid & 127, rg = tid >> 7;
    const int lane = tid & 63, w = tid >> 6, i = lane & 15, quad = lane >> 4; const int e0 = w * 32;
    f32x4 gdr = (f32x4){0.f, 0.f, 0.f, 0.f}; if (tid < 256) gdr = *(const f32x4*)(zs + (size_t)t0 * 32 + (tid >> 2) * 32 + (tid & 3) * 4);
    float wv[16]; { const float* wup = P.w_gk_up + (size_t)l * 16 * 512 + h * 128;
#pragma unroll
      for (int r = 0; r < 16; ++r) wv[r] = wup[r * 512 + d]; }
    const float bias = P.b_gk[l * 512 + h * 128 + d];
    bf16 qraw[16], kraw[16];
#pragma unroll
    for (int c = 0; c < 16; ++c) { const size_t zo = (size_t)(t0 + rg * 16 + c) * ZP + h * 128 + d; qraw[c] = z[zo + ZC_GQ]; kraw[c] = z[zo + ZC_GK]; }
    v4u vr[4]; load_v(z + (size_t)t0 * ZP + ZC_GV + h * 256, tid, vr);
    bf16x8 sfr[2][4];
    { const bf16* St = (const bf16*)(P.ws + WS_Y) + (size_t)item * 32768;
#pragma unroll
      for (int et = 0; et < 2; ++et)
#pragma unroll
          for (int ks = 0; ks < 4; ++ks) sfr[et][ks] = *(const bf16x8*)(St + (size_t)(e0 + et * 16 + i) * 128 + ks * 32 + quad * 8); }
    __syncthreads();
    if (tid < 256) *(LAS f32x4*)(GD + (tid >> 2) * 16 + (tid & 3) * 4) = gdr;
    store_v(VT, tid, vr);
    __syncthreads();
    float bv[16], blast;
    gla_decay(GD, TOT, tid, wv, bias, bv, blast);
#pragma unroll
    for (int c = 0; c < 16; ++c) { const int row = rg * 16 + c;
        const float q = bf2f(qraw[c]) * 0.08838834764831845f * __expf(bv[c]), k = bf2f(kraw[c]) * __expf(-bv[c]);
        *(LAS bf16*)(QT + row * 272 + d * 2) = (bf16)f2bf(q); *(LAS bf16*)(KT + row * 272 + d * 2) = (bf16)f2bf(k); }
    __syncthreads();
    { const int cpt = w & 3;
#pragma unroll
      for (int hf = 0; hf < 2; ++hf) { const int ct = 2 * (w >> 2) + hf; f32x4 a4 = (f32x4){0.f, 0.f, 0.f, 0.f};
#pragma unroll
          for (int ks = 0; ks < 4; ++ks) { const bf16x8 ka = *(const LAS bf16x8*)(KT + (cpt * 16 + i) * 272 + (ks * 32 + quad * 8) * 2), qb = *(const LAS bf16x8*)(QT + (ct * 16 + i) * 272 + (ks * 32 + quad * 8) * 2);
              a4 = MFMA16(ka, qb, a4); }
          const int cq = ct * 16 + i, ck = cpt * 16 + quad * 4;
          v2u o; o.x = pk2(ck <= cq ? a4[0] : 0.f, ck + 1 <= cq ? a4[1] : 0.f); o.y = pk2(ck + 2 <= cq ? a4[2] : 0.f, ck + 3 <= cq ? a4[3] : 0.f);
          *(LAS v2u*)(PL + cq * 144 + ck * 2) = o; } }
    __syncthreads();
    f32x4 acc[4][2];
#pragma unroll
    for (int ct = 0; ct < 4; ++ct) { acc[ct][0] = (f32x4){0.f, 0.f, 0.f, 0.f}; acc[ct][1] = (f32x4){0.f, 0.f, 0.f, 0.f}; }
#pragma unroll
    for (int ks = 0; ks < 4; ++ks) { const bf16x8 s0 = sfr[0][ks], s1 = sfr[1][ks];
#pragma unroll
        for (int ct = 0; ct < 4; ++ct) { const bf16x8 qa = *(const LAS bf16x8*)(QT + (ct * 16 + i) * 272 + (ks * 32 + quad * 8) * 2); acc[ct][0] = MFMA16(qa, s0, acc[ct][0]); acc[ct][1] = MFMA16(qa, s1, acc[ct][1]); } }
#pragma unroll
    for (int ks = 0; ks < 2; ++ks) { const LAS unsigned char* p0 = VT + (ks * 32 + quad * 8 + (i >> 2)) * 544 + (e0 + 4 * (i & 3)) * 2;
        const bf16x8 v0 = cat8(trread(p0), trread(p0 + 4 * 544)), v1 = cat8(trread(p0 + 32), trread(p0 + 32 + 4 * 544));
#pragma unroll
        for (int ct = 0; ct < 4; ++ct) { const bf16x8 pa = *(const LAS bf16x8*)(PL + (ct * 16 + i) * 144 + (ks * 32 + quad * 8) * 2); acc[ct][0] = MFMA16(pa, v0, acc[ct][0]); acc[ct][1] = MFMA16(pa, v1, acc[ct][1]); } }
    bf16 gra[4][4], grb[4][4];
#pragma unroll
    for (int ct = 0; ct < 4; ++ct)
#pragma unroll
        for (int j = 0; j < 4; ++j) { const size_t tt = (size_t)(t0 + ct * 16 + quad * 4 + j); gra[ct][j] = z[tt * ZP + ZC_GG + h * 256 + e0 + i]; grb[ct][j] = z[tt * ZP + ZC_GG + h * 256 + e0 + 16 + i]; }
#pragma unroll
    for (int ct = 0; ct < 4; ++ct)
#pragma unroll
        for (int j = 0; j < 4; ++j) { float s = acc[ct][0][j] * acc[ct][0][j] + acc[ct][1][j] * acc[ct][1][j];
            s = row16_sum(s);
            if (i == 0) PART[w * 64 + ct * 16 + quad * 4 + j] = s; }
    __syncthreads();
    if (tid < 64) { float s = 0.f;
#pragma unroll
        for (int ww = 0; ww < 8; ++ww) s += PART[ww * 64 + tid];
        PART[512 + tid] = rsqrtf(s * (1.0f / 256.0f) + 1e-6f); }
    __syncthreads();
    const float* gain = P.gla_norm_gain + l * 256; const float g0 = gain[e0 + i], g1 = gain[e0 + 16 + i];
    bf16* mix = (bf16*)(P.ws + WS_XB);
#pragma unroll
    for (int ct = 0; ct < 4; ++ct)
#pragma unroll
        for (int j = 0; j < 4; ++j) { const int c = ct * 16 + quad * 4 + j;
            const float r = PART[512 + c]; const size_t tt = (size_t)(t0 + c);
            const float ga = bf2f(gra[ct][j]), gb = bf2f(grb[ct][j]);
            mix[tt * 2048 + h * 256 + e0 + i] = (bf16)f2bf(acc[ct][0][j] * r * g0 * ga); mix[tt * 2048 + h * 256 + e0 + 16 + i] = (bf16)f2bf(acc[ct][1][j] * r * g1 * gb); }
}
__device__ __forceinline__ void mem_attn(const Params& P, int l, LAS unsigned char* lds, int item, int tid) {
    const int bh = item >> 3, qblk2 = (item & 7) * 2, b = bh >> 2, h = bh & 3;
    const bf16* z = (const bf16*)(P.ws + WS_Z); const bf16* mkv = (const bf16*)(P.ws + WS_MKV); bf16* mix = (bf16*)(P.ws + WS_XB);
    LAS unsigned char* KS = lds; LAS unsigned char* VS = lds + 69632;
    v4u kr[8], vr[8];
#pragma unroll
    for (int i = 0; i < 8; ++i) { const int idx = tid + 512 * i, key = idx >> 4, ch = idx & 15; const bf16* src = mkv + (size_t)(b * MEMLEN + key) * 2048 + l * 1024 + h * 128 + ch * 8; kr[i] = *(const v4u*)src; vr[i] = *(const v4u*)(src + 512); }
    __syncthreads();
#pragma unroll
    for (int i = 0; i < 8; ++i) { const int idx = tid + 512 * i, key = idx >> 4, ch = idx & 15; *(LAS v4u*)(KS + key * 272 + ch * 16) = kr[i]; *(LAS v4u*)(VS + key * 288 + ch * 16) = vr[i]; }
    __syncthreads();
    const int lane = tid & 63, w = tid >> 6, i = lane & 15, quad = lane >> 4;
    for (int pass = 0; pass < 4; ++pass) {
        const int q0 = (qblk2 + (pass >> 1)) * 256 + w * 32 + (pass & 1) * 16; const size_t tt = (size_t)(b * SEQ + q0 + i);
        bf16x8 qf[4];
#pragma unroll
        for (int ks = 0; ks < 4; ++ks) qf[ks] = *(const bf16x8*)(z + tt * ZP + ZC_MQ + h * 128 + ks * 32 + quad * 8);
        f32x4 sa[16];
#pragma unroll
        for (int kt = 0; kt < 16; ++kt) { sa[kt] = (f32x4){0.f, 0.f, 0.f, 0.f};
#pragma unroll
            for (int ks = 0; ks < 4; ++ks) { const bf16x8 ka = *(const LAS bf16x8*)(KS + (kt * 16 + i) * 272 + (ks * 32 + quad * 8) * 2); sa[kt] = MFMA16(ka, qf[ks], sa[kt]); }
            if (kt & 1) __builtin_amdgcn_sched_barrier(0); }
        float mx = -INFINITY;
#pragma unroll
        for (int kt = 0; kt < 16; ++kt) mx = fmaxf(fmaxf(fmaxf(sa[kt][0], sa[kt][1]), fmaxf(sa[kt][2], sa[kt][3])), mx);
        mx = fmaxf(mx, __shfl_xor(mx, 16)); mx = fmaxf(mx, __shfl_xor(mx, 32));
        const float sc = 0.08838834764831845f * 1.4426950408889634f; float lsum = 0.f;
#pragma unroll
        for (int kt = 0; kt < 16; ++kt)
#pragma unroll
            for (int j = 0; j < 4; ++j) { const float p = __builtin_amdgcn_exp2f((sa[kt][j] - mx) * sc); sa[kt][j] = p; lsum += p; }
        lsum += __shfl_xor(lsum, 16); lsum += __shfl_xor(lsum, 32);
        f32x4 oa[8];
#pragma unroll
        for (int et = 0; et < 8; ++et) oa[et] = (f32x4){0.f, 0.f, 0.f, 0.f};
#pragma unroll
        for (int s = 0; s < 8; ++s) { v4u pw; pw.x = pk2(sa[2 * s][0], sa[2 * s][1]); pw.y = pk2(sa[2 * s][2], sa[2 * s][3]); pw.z = pk2(sa[2 * s + 1][0], sa[2 * s + 1][1]); pw.w = pk2(sa[2 * s + 1][2], sa[2 * s + 1][3]);
            const bf16x8 pb = __builtin_bit_cast(bf16x8, pw);
            const LAS unsigned char* vp = VS + (32 * s + quad * 4 + (i >> 2)) * 288 + (4 * (i & 3)) * 2;
#pragma unroll
            for (int et = 0; et < 8; ++et) { const bf16x8 va = cat8(trread(vp + et * 32), trread(vp + et * 32 + 16 * 288)); oa[et] = MFMA16(va, pb, oa[et]); }
            __builtin_amdgcn_sched_barrier(0); }
        const float rl = 1.0f / lsum;
#pragma unroll
        for (int et = 0; et < 8; ++et) { const int e = et * 16 + quad * 4; const v2u g = *(const v2u*)(z + tt * ZP + ZC_MG + h * 128 + e);
            v2u o; o.x = pk2(oa[et][0] * rl * bf_lo(g.x), oa[et][1] * rl * bf_hi(g.x)); o.y = pk2(oa[et][2] * rl * bf_lo(g.y), oa[et][3] * rl * bf_hi(g.y));
            *(v2u*)(mix + tt * 2048 + 1536 + h * 128 + e) = o; }
    }
}
__device__ __forceinline__ void fox_seg(const Params& P, int l, int item, LAS float* scr, int tid) {
    const int bh = item >> 3, seg = item & 7, b = bh >> 3, h = bh & 7, pos = seg * 512 + tid;
    const float* zs = (const float*)(P.ws + WS_ZS); const bf16* z = (const bf16*)(P.ws + WS_Z); float* ft = (float*)(P.ws + WS_FOXT);
    const float lf = logsig(zs[(size_t)(b * SEQ + pos) * 32 + 16 + h] + P.b_f[l * 8 + h]);
    const bf16* zr = z + (size_t)(b * SEQ + pos) * ZP + h * 64; float sq = 0.f, sk = 0.f;
#pragma unroll
    for (int c = 0; c < 8; ++c) { const v4u a = *(const v4u*)(zr + ZC_FQ + c * 8), k4 = *(const v4u*)(zr + ZC_FK + c * 8);
#pragma unroll
        for (int e = 0; e < 4; ++e) { const float a0 = bf_lo(a[e]), a1 = bf_hi(a[e]), k0 = bf_lo(k4[e]), k1 = bf_hi(k4[e]); sq += a0 * a0 + a1 * a1; sk += k0 * k0 + k1 * k1; } }
    const int lane = tid & 63, w = tid >> 6; float inc = lf;
#pragma unroll
    for (int o = 1; o < 64; o <<= 1) { const float t = __shfl_up(inc, o); if (lane >= o) inc += t; }
#pragma unroll
    for (int o = 1; o < 64; o <<= 1) { sq = fmaxf(sq, __shfl_xor(sq, o)); sk = fmaxf(sk, __shfl_xor(sk, o)); }
    __syncthreads();
    if (lane == 63) { scr[w] = inc; scr[8 + w] = sq; scr[16 + w] = sk; }
    __syncthreads();
    float off = 0.f;
#pragma unroll
    for (int ww = 0; ww < 8; ++ww) if (ww < w) off += scr[ww];
    ft[FT_CBL + bh * 4096 + pos] = inc + off;
    if (tid == 511) ft[FT_SEG + bh * 8 + seg] = inc + off;
    if (tid == 0) { ft[FT_QNB + bh * 16 + 2 * seg] = fmaxf(fmaxf(scr[8], scr[9]), fmaxf(scr[10], scr[11])); ft[FT_QNB + bh * 16 + 2 * seg + 1] = fmaxf(fmaxf(scr[12], scr[13]), fmaxf(scr[14], scr[15]));
        float km = 0.f;
#pragma unroll
        for (int ww = 0; ww < 8; ++ww) km = fmaxf(km, scr[16 + ww]);
        ft[FT_KNS + bh * 8 + seg] = km; }
}
__device__ __forceinline__ void fox_bias(const Params& P, int bh, LAS float* cb, LAS float* wtot, int tid) {
    const float* ft = (const float*)(P.ws + WS_FOXT); const int w = tid >> 6;
    float off = 0.f, km = 0.f;
#pragma unroll
    for (int sg = 0; sg < 8; ++sg) { const float t = ft[FT_SEG + bh * 8 + sg]; if (sg < w) off += t; km = fmaxf(km, ft[FT_KNS + bh * 8 + sg]); }
    const f32x4 c0 = *(const f32x4*)(ft + FT_CBL + bh * 4096 + tid * 8), c1 = *(const f32x4*)(ft + FT_CBL + bh * 4096 + tid * 8 + 4);
    *(LAS f32x4*)(cb + tid * 8) = (c0 + off) * -1.4426950408889634f; *(LAS f32x4*)(cb + tid * 8 + 4) = (c1 + off) * -1.4426950408889634f;
    if (tid < 16) wtot[8 + tid] = ft[FT_QNB + bh * 16 + tid];
    if (tid == 16) wtot[24] = km;
    __syncthreads();
}
#define FOX_MARGIN 50.0f
__device__ __forceinline__ int fox_skip(const LAS float* cb, const LAS float* wtot, int qb, int tid) {
    const float qn = wtot[8 + qb], kn = wtot[24];
    const float smax = sqrtf(qn) * sqrtf(kn) * 1.0001f + 1e-3f;
    const int lane = tid & 63; const float thr = cb[qb * 256] - 2.0f * smax - FOX_MARGIN;
    const unsigned long long m = __ballot(cb[lane * 64 + 63] <= thr);
    int t0 = __builtin_popcountll(m) & ~1; const int nt = 4 * qb + 4; if (t0 > nt - 4) t0 = nt - 4;
    return __builtin_amdgcn_readfirstlane(t0);
}
__device__ __forceinline__ void side_gemm(const Params& P, int l, int tid, int G) {
    const bf16* XBp = (const bf16*)(P.ws + WS_XB); const bf16* Wt = (const bf16*)(P.ws + WS_WIN) + (size_t)l * NZ * 2048 + (size_t)12288 * 2048;
    float* zs = (float*)(P.ws + WS_ZS);
    const int lane = tid & 63, w = tid >> 6, i = lane & 15, quad = lane >> 4;
    for (int blk = blockIdx.x; blk < T / 64; blk += G) {
        const int row0 = blk * 64 + (w >> 1) * 16, ct = w & 1;
        const bf16* ap = XBp + (size_t)(row0 + i) * 2048 + quad * 8; const bf16* bp = Wt + (size_t)(ct * 16 + i) * 2048 + quad * 8;
        f32x4 acc = (f32x4){0.f, 0.f, 0.f, 0.f};
#pragma unroll 16
        for (int ks = 0; ks < 64; ++ks) { const bf16x8 a = *(const bf16x8*)(ap + ks * 32), b = *(const bf16x8*)(bp + ks * 32); acc = MFMA16(a, b, acc); }
#pragma unroll
        for (int j = 0; j < 4; ++j) { const int row = row0 + quad * 4 + j; zs[(size_t)row * 32 + ct * 16 + i] = acc[j]; }
    }
}
__device__ __forceinline__ void final_norm(const Params& P, int tid, int G) {
    const int lane = tid & 63, wave = tid >> 6; const float* ss = (const float*)(P.ws + WS_SS) + 2 * T;
    for (int m = blockIdx.x * NWAVES + wave; m < T; m += G * NWAVES) { const float r = rsqrtf(ss[m] * (1.0f / 2048.0f) + 1e-6f);
        f32x4* xr = (f32x4*)(P.out + (size_t)m * DM) + lane; const f32x4* gr = (const f32x4*)P.final_gain + lane;
#pragma unroll
        for (int j = 0; j < 8; ++j) { const f32x4 v = xr[64 * j], g = gr[64 * j]; xr[64 * j] = v * r * g; } }
}

#ifndef P1_ALIGN
#define P1_ALIGN true
#endif
#ifndef P1_SP2
#define P1_SP2 true
#endif
#ifndef REPEAT_MASK
#define REPEAT_MASK 0
#endif
__global__ void __launch_bounds__(NTHR, 2) fwd_mega(Params P) {
    extern __shared__ __attribute__((aligned(16))) unsigned char lds_raw[];
    cg::grid_group grid = cg::this_grid();
    LAS unsigned char* lds = (LAS unsigned char*)lds_raw;
    const int tid = threadIdx.x, G = gridDim.x, bx = blockIdx.x;
    unsigned char* ws = P.ws;
    volatile LAS unsigned* bst = (volatile LAS unsigned*)(lds + LDS_BYTES - 16);
    if (tid < 4) bst[tid] = 0u;
    __syncthreads();
    XcdBarrier xbar = xcd_barrier_post((unsigned*)(ws + WS_CTL), bst);
    bf16* XB = (bf16*)(ws + WS_XB); bf16* Z = (bf16*)(ws + WS_Z); float* ZS = (float*)(ws + WS_ZS); float* SS = (float*)(ws + WS_SS);

    for (int rep_ = 0; rep_ < 1 + ((REPEAT_MASK >> 7) & 1); ++rep_)
    { int tp = tid; asm volatile("" : "+v"(tp)); phase_prologue(P, lds, tp, G); }
    if (P.out == nullptr) grid.sync();
    xcd_barrier(xbar);
    for (int l = 0; l < DEPTH; ++l) {
        for (int rep_ = 0; rep_ < 1 + ((REPEAT_MASK >> 5) & 1); ++rep_)
        { pg8::Gemm g{XB, (const bf16*)(ws + WS_WIN) + (size_t)l * NZ * 2048, T, ZP, 2048}; pg8::StaticOrder S; S.init(T, ZP, G, bx);
          pg8::EpiZ E{Z, ZP, 0};
          pg8::gemm_phase<pg8::EpiZ, pg8::StaticOrder, P1_ALIGN, P1_SP2>(lds, g, S, E); }
        { int tp = tid; asm volatile("" : "+v"(tp)); side_gemm(P, l, tp, G); }
        if (l == 0) { pg8::Gemm g{(const bf16*)(ws + WS_MEMB), (const bf16*)(ws + WS_WKV), MROWS, 2048, 2048}; pg8::TailOrder S{bx, G - 32, 4};
          pg8::EpiZ E{(bf16*)(ws + WS_MKV), 2048, 1};
          pg8::gemm_phase<pg8::EpiZ, pg8::TailOrder, true, true>(lds, g, S, E); }
        xcd_barrier(xbar);
        for (int rep_ = 0; rep_ < 1 + ((REPEAT_MASK >> 0) & 1); ++rep_)
        { G1Pre R1; int tp = tid; asm volatile("" : "+v"(tp));
          if (bx < 1024) gla_step1_pre(P, bx, tp, R1);
          for (int it = bx; it < 1024; it += G) { asm volatile("" : "+v"(tp)); gla_step1(P, l, lds, it, it + G < 1024 ? it + G : -1, tp, R1); } }
        xcd_barrier(xbar);
        { const int hg = G >> 1;
          if (bx < hg) { int tp = tid; asm volatile("" : "+v"(tp)); gla_scan(P, tp, bx, hg);
              for (int it = bx; it < 256; it += hg) { asm volatile("" : "+v"(tp)); fox_seg(P, l, it, (LAS float*)lds, tp); } }
          else for (int it = bx - hg; it < 128; it += G - hg) { int tp = tid; asm volatile("" : "+v"(tp)); mem_attn(P, l, lds, it, tp); } }
        xcd_barrier(xbar);
        for (int rep_ = 0; rep_ < 1 + ((REPEAT_MASK >> 3) & 1); ++rep_)
        { const int vcu = (G % 8 == 0) ? (bx % 8) * (G / 8) + bx / 8 : bx;
          for (int pr = vcu; pr < 256; pr += G) { const int bh = pr >> 3, s = pr & 7, b = bh >> 3, h = bh & 7;
              __syncthreads();
              { int tp = tid; asm volatile("" : "+v"(tp)); fox_bias(P, bh, (LAS float*)(lds + 86016), (LAS float*)(lds + 102400), tp); }
              for (int k = 0; k < 2; ++k) { const int qb = k == 0 ? 15 - s : s; const int t0s = fox_skip((const LAS float*)(lds + 86016), (const LAS float*)(lds + 102400), qb, tid);
                  attn_body::attn_unit<40>(b, h, qb, (const attn_body::bf16*)(Z + ZC_FQ), (const attn_body::bf16*)(Z + ZC_FK), (const attn_body::bf16*)(Z + ZC_FV), (attn_body::bf16*)(XB + 1024),
                                          (const attn_body::bf16*)(Z + ZC_FG), (attn_body::lds_f4p)(lds + 86016), t0s, (char*)lds_raw); } } }
        for (int rep_ = 0; rep_ < 1 + ((REPEAT_MASK >> 4) & 1); ++rep_)
        for (int it = bx; it < 1024; it += G) { int tp = tid; asm volatile("" : "+v"(tp)); gla_step3(P, l, lds, it, tp); }
        xcd_barrier(xbar);
        for (int rep_ = 0; rep_ < 1 + ((REPEAT_MASK >> 6) & 1); ++rep_)
        { pg8::Gemm g{XB, (const bf16*)(ws + WS_WBR) + (size_t)l * 2048 * 2048, T, 2048, 2048}; pg8::StaticOrder S; S.init(T, 2048, G, bx);
          pg8::EpiY E{(bf16*)(ws + WS_Y), Z + ZC_MERGE, ZP};
          pg8::gemm_phase<pg8::EpiY, pg8::StaticOrder, true, true>(lds, g, S, E); }
        xcd_barrier(xbar);
        { pg8::Gemm g{(const bf16*)(ws + WS_Y), (const bf16*)(ws + WS_WOUT) + (size_t)l * 2048 * 2048, T, 2048, 2048}; pg8::StaticOrder S; S.init(T, 2048, G, bx);
          unsigned* pcnt = (unsigned*)(ws + WS_CTL + 16384) + l * 4096;
          if (G == 256 && l == DEPTH - 1) { pg8::EpiXF<true> E{P.out, P.out, nullptr, SS + (l + 1) * T, pcnt, P.final_gain};
              pg8::gemm_phase<pg8::EpiXF<true>, pg8::StaticOrder, true, true>(lds, g, S, E); }
          else if (G == 256) { pg8::EpiXF<false> E{l == 0 ? P.x : P.out, P.out, XB, SS + (l + 1) * T, pcnt, nullptr};
              pg8::gemm_phase<pg8::EpiXF<false>, pg8::StaticOrder, true, true>(lds, g, S, E); }
          else { pg8::EpiX E{l == 0 ? P.x : P.out, P.out, l == DEPTH - 1 ? nullptr : XB, SS + (l + 1) * T};
              pg8::gemm_phase<pg8::EpiX, pg8::StaticOrder, true, true>(lds, g, S, E); } }
        if (!(l == DEPTH - 1 && G == 256)) xcd_barrier(xbar);
        if (G != 256 && l < DEPTH - 1) { int tp = tid; asm volatile("" : "+v"(tp)); rescale_rows(XB, SS + (l + 1) * T, tp, G); xcd_barrier(xbar); }
    }
    if (G == 256) return;
#ifdef EXTRA_SYNCS
    for (int k_ = 0; k_ < EXTRA_SYNCS; ++k_) xcd_barrier(xbar);
#endif
    { int tp = tid; asm volatile("" : "+v"(tp)); final_norm(P, tp, G); }
}

extern "C" void kernel_launch(void* const* d_in, const int* in_sizes, int n_in, void* d_out, int out_size, void* d_ws, size_t ws_size, hipStream_t stream) {
    static int grid = 0;
    if (grid == 0) {
        if (n_in != 13 || ws_size < WS_END) { fprintf(stderr, "kernel_launch: need 13 inputs and >= %zu bytes of workspace (got %d, %zu)\n", (size_t)WS_END, n_in, ws_size); grid = -1; return; }
        int dev = 0, cus = 0, per_cu = 0;
        (void)hipGetDevice(&dev); (void)hipDeviceGetAttribute(&cus, hipDeviceAttributeMultiprocessorCount, dev);
        if (hipFuncSetAttribute((const void*)fwd_mega, hipFuncAttributeMaxDynamicSharedMemorySize, LDS_BYTES) != hipSuccess) { fprintf(stderr, "kernel_launch: hipFuncSetAttribute failed\n"); grid = -1; return; }
        if (hipOccupancyMaxActiveBlocksPerMultiprocessor(&per_cu, (const void*)fwd_mega, NTHR, LDS_BYTES) != hipSuccess || per_cu < 1) { fprintf(stderr, "kernel_launch: occupancy query says %d blocks/CU\n", per_cu); per_cu = 1; }
        (void)hipGetLastError();
        grid = cus;
    }
    if (grid < 0) return;
    Params p{};
    p.x = (const float*)d_in[0]; p.mem = (const float*)d_in[1]; p.norm_gain = (const float*)d_in[2]; p.w_in = (const float*)d_in[3]; p.w_gk_up = (const float*)d_in[4];
    p.b_gk = (const float*)d_in[5]; p.gla_norm_gain = (const float*)d_in[6]; p.b_f = (const float*)d_in[7]; p.mem_norm_gain = (const float*)d_in[8]; p.w_mem_kv = (const float*)d_in[9];
    p.w_branch = (const float*)d_in[10]; p.w_out = (const float*)d_in[11]; p.final_gain = (const float*)d_in[12];
    p.out = (float*)d_out; p.ws = (unsigned char*)d_ws;
    if (hipMemsetAsync((char*)d_ws + WS_CTL, 0, CTL_ZERO_BYTES, stream) != hipSuccess) { fprintf(stderr, "kernel_launch: memset failed\n"); return; }
    void* args[] = {&p};
    hipError_t e = hipLaunchCooperativeKernel((const void*)fwd_mega, dim3(grid), dim3(NTHR), args, LDS_BYTES, stream);
    if (e != hipSuccess) fprintf(stderr, "kernel_launch: cooperative launch failed: %s (grid %d)\n", hipGetErrorString(e), grid);
}
```

```cpp
#define PG8_ROT 1
#include <hip/hip_runtime.h>
#include <hip/hip_cooperative_groups.h>
#include <hip/hip_bf16.h>
#include <cstdio>
#include <cstdint>
#include <cmath>
namespace cg = cooperative_groups;
namespace pg8 {
#define PG8_LAS __attribute__((address_space(3)))
typedef unsigned short bf16_t;
typedef short bf16x8 __attribute__((ext_vector_type(8)));
typedef float f32x4 __attribute__((ext_vector_type(4)));
typedef unsigned u32x4 __attribute__((ext_vector_type(4)));
constexpr int BM = 256, BK = 64, HALF = 128, HTB = HALF * BK * 2  , STAGE_BYTES = 8 * HTB, NXCD = 8;
#ifndef PG8_WGM
#define PG8_WGM 4
#endif
constexpr int WGM = PG8_WGM;

__host__ __device__ __forceinline__ int lds_byte(int r, int c) { const int st = (r >> 4) * 2 + (c >> 5), rr = r & 15, cc = c & 31, ob = rr * 64 + cc * 2; return st * 1024 + (ob ^ (((ob >> 9) & 1) << 5)); }
__host__ __device__ __forceinline__ void stage_rc(int b, int& R, int& C) { const int st = b / 1024, sb = b % 1024, swz = sb ^ (((sb >> 9) & 1) << 5); R = (st >> 1) * 16 + swz / 64; C = (st & 1) * 32 + (swz % 64) / 2; }
__host__ __device__ __forceinline__ int perm32(int rho) { const int n = rho >> 4, i = rho & 15; return 8 * (i >> 2) + 4 * n + (i & 3); }

struct Unit { int pm, pn; };
struct Gemm { const bf16_t* A; const bf16_t* Bt; int M, N, K; };

struct StaticOrder {
    int nM, nN, nwg, G, c;
    __host__ __device__ void init(int M, int N, int G_, int c_) { nM = M / BM; nN = N / BM; nwg = nM * nN; G = G_; c = c_; }
    __host__ __device__ bool next(int i, Unit& u) const {
        const long L = (long)i * G + c; if (L >= nwg) return false;
        int wgid = (int)L; const int xcd_ = wgid % NXCD; { const int q = nwg / NXCD, r = nwg % NXCD, xcd = wgid % NXCD, off = wgid / NXCD; wgid = (xcd < r ? xcd * (q + 1) : r * (q + 1) + (xcd - r) * q) + off; }
        const int nig = WGM * nN, gid = wgid / nig, fm = gid * WGM, gsz = (nM - fm) < WGM ? (nM - fm) : WGM;
        u.pm = fm + ((wgid % nig) % gsz); u.pn = (wgid % nig) / gsz;
#ifdef PG8_ROT
        if (nN >= 16) { u.pn += xcd_ * (nN / NXCD); if (u.pn >= nN) u.pn -= nN; }
#endif
        return true;
    }
    __device__ __forceinline__ void a_ready(const Unit&) const {}
    __device__ __forceinline__ void done(const Unit&) const {}
};

typedef float f32x2e_t __attribute__((ext_vector_type(2))); typedef __bf16 bf16x2e_t __attribute__((ext_vector_type(2)));
__device__ __forceinline__ unsigned cvt_pk_bf16(float lo, float hi) { const f32x2e_t v = {lo, hi}; return __builtin_bit_cast(unsigned, __builtin_convertvector(v, bf16x2e_t)); }
__device__ __forceinline__ float bf_lo(unsigned u) { return __uint_as_float(u << 16); }
__device__ __forceinline__ float bf_hi(unsigned u) { return __uint_as_float(u & 0xffff0000u); }
__device__ __forceinline__ float fsigmoid(float v) { return __builtin_amdgcn_rcpf(1.f + __expf(-v)); }

struct EpiZ {
    static constexpr bool PERM = true, AFTER_DRAIN = false, HAS_MID = false; static constexpr int MID0 = -1, MID1 = -1;
    bf16_t* Z; int ldz; int kind;
    __device__ __forceinline__ void mid(f32x4 (&acc)[2][2][4][2], const Unit& u, int wr, int wc, int fr, int fq, int which) const {}
    __device__ __forceinline__ void operator()(const f32x4 (&acc)[2][2][4][2], const Unit& u, int wr, int wc, int fr, int fq) const {
        const int row0 = u.pm * BM + wr * 64 + fr;
        int mode = 0; const int pn = u.pn;
        if (kind == 0) {
            if (pn >= 24) mode = 3;
            else if ((pn >= 8 && pn < 12) || pn == 18 || pn == 19 || pn == 22 || pn == 23) mode = 2;
            else if (pn == 12 || pn == 13) mode = 1;
        }
        const int col0 = pn * BM + wc * 32 + 8 * fq;
#pragma unroll
        for (int ai = 0; ai < 2; ++ai)
#pragma unroll
            for (int m = 0; m < 4; ++m) { bf16_t* rowp = Z + (size_t)(row0 + ai * HALF + m * 16) * ldz + col0;
#pragma unroll
                for (int bj = 0; bj < 2; ++bj) { f32x4 v0 = acc[ai][bj][m][0], v1 = acc[ai][bj][m][1];
                    if (mode == 1) { v0 = v0 * 0.18033688011112042f; v1 = v1 * 0.18033688011112042f; }
                    else if (mode == 2) {
#pragma unroll
                        for (int j = 0; j < 4; ++j) { v0[j] = v0[j] * fsigmoid(v0[j]); v1[j] = v1[j] * fsigmoid(v1[j]); } }
                    else if (mode == 3) {
#pragma unroll
                        for (int j = 0; j < 4; ++j) { v0[j] = fsigmoid(v0[j]); v1[j] = fsigmoid(v1[j]); } }
                    u32x4 w; w.x = cvt_pk_bf16(v0[0], v0[1]); w.y = cvt_pk_bf16(v0[2], v0[3]); w.z = cvt_pk_bf16(v1[0], v1[1]); w.w = cvt_pk_bf16(v1[2], v1[3]);
                    *(u32x4*)(rowp + bj * HALF) = w; } }
    }
};

struct EpiY {
    static constexpr bool PERM = true, AFTER_DRAIN = false, HAS_MID = true; static constexpr int MID0 = 16, MID1 = 24;
    bf16_t* Y; const bf16_t* Zg; int ldz;
    __device__ __forceinline__ void mid(f32x4 (&acc)[2][2][4][2], const Unit& u, int wr, int wc, int fr, int fq, int which) const {
        int row0 = u.pm * BM + wr * 64 + fr; asm volatile("" : "+v"(row0)); const int col0 = u.pn * BM + wc * 32 + 8 * fq + which * 2048;
#pragma unroll
        for (int ai = 0; ai < 2; ++ai) {
            u32x4 ga[4][2], gb[4][2];
#pragma unroll
            for (int m = 0; m < 4; ++m) { const bf16_t* rowp = Zg + (size_t)(row0 + ai * HALF + m * 16) * ldz + col0;
#pragma unroll
                for (int bj = 0; bj < 2; ++bj) { ga[m][bj] = *(const u32x4*)(rowp + bj * HALF); gb[m][bj] = *(const u32x4*)(rowp + bj * HALF + 2048); } }
#pragma unroll
            for (int m = 0; m < 4; ++m)
#pragma unroll
                for (int bj = 0; bj < 2; ++bj)
#pragma unroll
                    for (int e = 0; e < 4; ++e) { const float r0 = bf_lo(ga[m][bj][e]) * __builtin_amdgcn_rcpf(fmaxf(bf_lo(gb[m][bj][e]), 1e-30f)), r1 = bf_hi(ga[m][bj][e]) * __builtin_amdgcn_rcpf(fmaxf(bf_hi(gb[m][bj][e]), 1e-30f));
                        acc[ai][bj][m][e >> 1][(e & 1) * 2] *= r0; acc[ai][bj][m][e >> 1][(e & 1) * 2 + 1] *= r1; }
            __builtin_amdgcn_sched_barrier(0); }
        asm volatile("s_waitcnt vmcnt(0)" ::: "memory");
    }
    __device__ __forceinline__ void operator()(const f32x4 (&acc)[2][2][4][2], const Unit& u, int wr, int wc, int fr, int fq) const {
        const int row0 = u.pm * BM + wr * 64 + fr, col0 = u.pn * BM + wc * 32 + 8 * fq;
#pragma unroll
        for (int ai = 0; ai < 2; ++ai)
#pragma unroll
            for (int m = 0; m < 4; ++m) { const size_t r = (size_t)(row0 + ai * HALF + m * 16);
#pragma unroll
                for (int bj = 0; bj < 2; ++bj) { const u32x4 g = *(const u32x4*)(Zg + r * ldz + 4096 + col0 + bj * HALF);
                    const f32x4 a0 = acc[ai][bj][m][0], a1 = acc[ai][bj][m][1]; u32x4 w;
                    w.x = cvt_pk_bf16(a0[0] * bf_lo(g.x), a0[1] * bf_hi(g.x)); w.y = cvt_pk_bf16(a0[2] * bf_lo(g.y), a0[3] * bf_hi(g.y));
                    w.z = cvt_pk_bf16(a1[0] * bf_lo(g.z), a1[1] * bf_hi(g.z)); w.w = cvt_pk_bf16(a1[2] * bf_lo(g.w), a1[3] * bf_hi(g.w));
                    *(u32x4*)(Y + r * 2048 + col0 + bj * HALF) = w; }
                __builtin_amdgcn_sched_barrier(0); }
    }
};

struct EpiX {
    static constexpr bool PERM = false, AFTER_DRAIN = false, HAS_MID = false; static constexpr int MID0 = -1, MID1 = -1;
    const float* Xin; float* Xout; bf16_t* XB; float* ssq;
    __device__ __forceinline__ void mid(f32x4 (&acc)[2][2][4][2], const Unit& u, int wr, int wc, int fr, int fq, int which) const {}
    __device__ __forceinline__ void operator()(const f32x4 (&acc)[2][2][4][2], const Unit& u, int wr, int wc, int fr, int fq) const {
        const int row0 = u.pm * BM + wr * 64 + fr, col0 = u.pn * BM + wc * 32 + 4 * fq;
#pragma unroll
        for (int ai = 0; ai < 2; ++ai)
#pragma unroll
            for (int m = 0; m < 4; ++m) { const int row = row0 + ai * HALF + m * 16; const size_t off = (size_t)row * 2048 + col0; float ss = 0.f;
#pragma unroll
                for (int bj = 0; bj < 2; ++bj)
#pragma unroll
                    for (int n = 0; n < 2; ++n) { const size_t o = off + bj * HALF + n * 16; const f32x4 xo = *(const f32x4*)(Xin + o) + acc[ai][bj][m][n];
                        *(f32x4*)(Xout + o) = xo; ss += (xo[0] * xo[0] + xo[1] * xo[1]) + (xo[2] * xo[2] + xo[3] * xo[3]);
                        if (XB) { unsigned long long w = (unsigned long long)cvt_pk_bf16(xo[0], xo[1]) | ((unsigned long long)cvt_pk_bf16(xo[2], xo[3]) << 32); *(unsigned long long*)(XB + o) = w; } }
                ss += __shfl_xor(ss, 16); ss += __shfl_xor(ss, 32);
                if (fq == 0) atomicAdd(ssq + row, ss); }
    }
};
template <bool FINAL> struct EpiXF {
    static constexpr bool PERM = false, AFTER_DRAIN = false, HAS_MID = false; static constexpr int MID0 = -1, MID1 = -1;
    const float* Xin; float* X; bf16_t* XB; float* ssq; unsigned* cnt; const float* fgain;
    __device__ __forceinline__ void mid(f32x4 (&acc)[2][2][4][2], const Unit& u, int wr, int wc, int fr, int fq, int which) const {}
    __device__ __forceinline__ void operator()(f32x4 (&acc)[2][2][4][2], const Unit& u, int wr, int wc, int fr, int fq) const {
        const int row0 = u.pm * BM + wr * 64 + fr, col0 = u.pn * BM + wc * 32 + 4 * fq;
#pragma unroll
        for (int ai = 0; ai < 2; ++ai)
#pragma unroll
            for (int m = 0; m < 4; ++m) { const int row = row0 + ai * HALF + m * 16; const size_t off = (size_t)row * 2048 + col0; float ss = 0.f;
#pragma unroll
                for (int bj = 0; bj < 2; ++bj)
#pragma unroll
                    for (int n = 0; n < 2; ++n) { const f32x4 xo = *(const f32x4*)(Xin + off + bj * HALF + n * 16) + acc[ai][bj][m][n]; acc[ai][bj][m][n] = xo;
                        if (!FINAL) *(f32x4*)(X + off + bj * HALF + n * 16) = xo;
                        ss += (xo[0] * xo[0] + xo[1] * xo[1]) + (xo[2] * xo[2] + xo[3] * xo[3]); }
                ss += __shfl_xor(ss, 16); ss += __shfl_xor(ss, 32);
                if (fq == 0) atomicAdd(ssq + row, ss); }
        asm volatile("s_waitcnt vmcnt(0)" ::: "memory");
        __builtin_amdgcn_s_barrier();
        if (threadIdx.x == 0) { unsigned* c = cnt + 64 * u.pm; __hip_atomic_fetch_add(c, 1u, __ATOMIC_RELAXED, __HIP_MEMORY_SCOPE_AGENT);
            unsigned sp = 0; while (__hip_atomic_load(c, __ATOMIC_RELAXED, __HIP_MEMORY_SCOPE_AGENT) < 8u && ++sp < (1u << 22)) __builtin_amdgcn_s_sleep(2);
            __builtin_amdgcn_fence(__ATOMIC_ACQUIRE, "agent"); }
        asm volatile("s_waitcnt vmcnt(0) lgkmcnt(0)" ::: "memory");
        __builtin_amdgcn_s_barrier();
        asm volatile("" ::: "memory");
        f32x4 gv[2][2];
        if (FINAL) {
#pragma unroll
            for (int bj = 0; bj < 2; ++bj)
#pragma unroll
                for (int n = 0; n < 2; ++n) gv[bj][n] = *(const f32x4*)(fgain + col0 + bj * HALF + n * 16); }
#pragma unroll
        for (int ai = 0; ai < 2; ++ai)
#pragma unroll
            for (int m = 0; m < 4; ++m) { const int row = row0 + ai * HALF + m * 16; const size_t off = (size_t)row * 2048 + col0;
                const float r = rsqrtf(__hip_atomic_load(ssq + row, __ATOMIC_RELAXED, __HIP_MEMORY_SCOPE_AGENT) * (1.0f / 2048.0f) + 1e-6f);
#pragma unroll
                for (int bj = 0; bj < 2; ++bj)
#pragma unroll
                    for (int n = 0; n < 2; ++n) { const f32x4 xo = acc[ai][bj][m][n] * r;
                        if (FINAL) *(f32x4*)(X + off + bj * HALF + n * 16) = xo * gv[bj][n];
                        else { unsigned long long w = (unsigned long long)cvt_pk_bf16(xo[0], xo[1]) | ((unsigned long long)cvt_pk_bf16(xo[2], xo[3]) << 32); *(unsigned long long*)(XB + off + bj * HALF + n * 16) = w; } } }
    }
};
struct TailOrder {
    int c, first, nM;
    __device__ __forceinline__ bool next(int i, Unit& u) const { if (i > 0 || c < first) return false; const int idx = c - first; u.pm = idx % nM; u.pn = idx / nM; return true; }
    __device__ __forceinline__ void a_ready(const Unit&) const {}
    __device__ __forceinline__ void done(const Unit&) const {}
};
template <class Epi, class Sched, bool ALIGN_EPI = false, bool SP2 = false>
__device__ __forceinline__ void gemm_phase(PG8_LAS unsigned char* lds, const Gemm g, const Sched& S, const Epi& E) {
    int tid_ = threadIdx.x; asm volatile("" : "+v"(tid_));
    const int tid = tid_, wid = __builtin_amdgcn_readfirstlane(tid >> 6), lane = tid & 63, wr = wid >> 2, wc = wid & 3, fr = lane & 15, fq = lane >> 4;
    const int K = g.K, nt = K / BK;
    unsigned voffA[2], voffB[2];
#pragma unroll
    for (int i = 0; i < 2; ++i) { int R, C; stage_rc(tid * 16 + i * 8192, R, C); const int Rb = Epi::PERM ? ((R & ~31) + perm32(R & 31)) : R;
        voffA[i] = (unsigned)(R * K + C) * 2u; voffB[i] = (unsigned)(Rb * K + C) * 2u; }
    const size_t kstep = (size_t)(BK * 2);
    const size_t hstep = (size_t)HALF * K * 2;
    const size_t tstep = 2 * hstep;
    const unsigned ldsw = (unsigned)wid * 1024u;
    const int aoff = lds_byte(wr * 64 + fr, fq * 8), boff = lds_byte(wc * 32 + fr, fq * 8);
#define PG8_SA(b, h) (((b) * 2 + (h)) * HTB)
#define PG8_SB(b, h) ((4 + (b) * 2 + (h)) * HTB)
#define PG8_STAGE(bufoff, gbase, voff) do { _Pragma("unroll") for (int _i = 0; _i < 2; ++_i) \
        __builtin_amdgcn_global_load_lds((const unsigned*)((const char*)(gbase) + (voff)[_i]), (PG8_LAS unsigned*)(lds + (bufoff) + ldsw + _i * 8192), 16, 0, 0); } while (0)
#define PG8_LDA(dst, b, h) do { _Pragma("unroll") for (int m = 0; m < 4; ++m) _Pragma("unroll") for (int k = 0; k < 2; ++k) dst[m][k] = *(const PG8_LAS bf16x8*)(lds + PG8_SA(b, h) + aoff + m * 2048 + k * 1024); } while (0)
#define PG8_LDB(dst, b, h) do { _Pragma("unroll") for (int n = 0; n < 2; ++n) _Pragma("unroll") for (int k = 0; k < 2; ++k) dst[n][k] = *(const PG8_LAS bf16x8*)(lds + PG8_SB(b, h) + boff + n * 2048 + k * 1024); } while (0)
#define PG8_MMA(ai, bj, At, Bt) do { __builtin_amdgcn_s_setprio(1); _Pragma("unroll") for (int m = 0; m < 4; ++m) _Pragma("unroll") for (int n = 0; n < 2; ++n) _Pragma("unroll") for (int k = 0; k < 2; ++k) \
        acc[ai][bj][m][n] = __builtin_amdgcn_mfma_f32_16x16x32_bf16(Bt[n][k], At[m][k], acc[ai][bj][m][n], 0, 0, 0); __builtin_amdgcn_s_setprio(0); } while (0)
#define PG8_WAIT_V(n) asm volatile("s_waitcnt vmcnt(" #n ")" ::: "memory")
#define PG8_WAIT_L(n) asm volatile("s_waitcnt lgkmcnt(" #n ")" ::: "memory")
#define PG8_BAR __builtin_amdgcn_s_barrier()
#define PG8_SCHED __builtin_amdgcn_sched_barrier(0)
    Unit cur, nxt; int ui = 0;
    if (!S.next(0, cur)) return;
    f32x4 acc[2][2][4][2];
#pragma unroll
    for (int a = 0; a < 2; ++a)
#pragma unroll
        for (int b = 0; b < 2; ++b)
#pragma unroll
            for (int m = 0; m < 4; ++m)
#pragma unroll
                for (int n = 0; n < 2; ++n) acc[a][b][m][n] = (f32x4){0.f, 0.f, 0.f, 0.f};
    bf16x8 At[4][2], B0[2][2], B1[2][2];
    const char* cA = (const char*)g.A + (size_t)cur.pm * tstep; const char* cB = (const char*)g.Bt + (size_t)cur.pn * tstep;
    S.a_ready(cur);
    if constexpr (SP2) {
        PG8_STAGE(PG8_SB(0, 0), cB, voffB); PG8_STAGE(PG8_SB(0, 1), cB + hstep, voffB); PG8_STAGE(PG8_SA(0, 0), cA, voffA); PG8_STAGE(PG8_SA(0, 1), cA + hstep, voffA);
        if (wr == 1) PG8_BAR;
        PG8_WAIT_V(2); PG8_BAR;
        PG8_STAGE(PG8_SB(1, 0), cB + kstep, voffB); PG8_STAGE(PG8_SA(1, 0), cA + kstep, voffA); PG8_STAGE(PG8_SB(1, 1), cB + hstep + kstep, voffB);
        PG8_WAIT_V(6); PG8_BAR;
    } else {
        PG8_STAGE(PG8_SB(0, 0), cB, voffB); PG8_STAGE(PG8_SA(0, 0), cA, voffA); PG8_STAGE(PG8_SB(0, 1), cB + hstep, voffB); PG8_STAGE(PG8_SA(0, 1), cA + hstep, voffA);
        if (wr == 1) PG8_BAR;
        PG8_WAIT_V(4); PG8_BAR;
        PG8_STAGE(PG8_SB(1, 0), cB + kstep, voffB); PG8_STAGE(PG8_SA(1, 0), cA + kstep, voffA); PG8_STAGE(PG8_SB(1, 1), cB + hstep + kstep, voffB);
        PG8_WAIT_V(6); PG8_BAR;
    }
    for (;;) {
        const bool has_next = S.next(ui + 1, nxt);
        const char* nA = has_next ? (const char*)g.A + (size_t)nxt.pm * tstep : cA; const char* nB = has_next ? (const char*)g.Bt + (size_t)nxt.pn * tstep : cB;
        for (int t = 0; t < nt; t += 2) {
            if constexpr (Epi::HAS_MID) { if (t == Epi::MID0 || t == Epi::MID1) E.mid(acc, cur, wr, wc, fr, fq, t == Epi::MID0 ? 0 : 1); }
            const bool last = (t == nt - 2);
            const char* a1 = cA + (size_t)(t + 1) * kstep;
            const char* a2 = last ? nA : cA + (size_t)(t + 2) * kstep; const char* b2 = last ? nB : cB + (size_t)(t + 2) * kstep;
            const char* a3 = a2 + kstep; const char* b3 = b2 + kstep;
            if (last && has_next) S.a_ready(nxt);
            if constexpr (SP2) {
            PG8_LDB(B0, 0, 0); PG8_LDB(B1, 0, 1); PG8_SCHED; PG8_LDA(At, 0, 0); PG8_STAGE(PG8_SA(1, 1), a1 + hstep, voffA);
            PG8_WAIT_V(8); PG8_WAIT_L(0); PG8_BAR; PG8_MMA(0, 0, At, B0); PG8_MMA(0, 1, At, B1); PG8_BAR; PG8_SCHED;
            PG8_LDA(At, 0, 1); PG8_STAGE(PG8_SB(0, 0), b2, voffB); PG8_STAGE(PG8_SB(0, 1), b2 + hstep, voffB); PG8_STAGE(PG8_SA(0, 0), a2, voffA);
            PG8_WAIT_V(8); PG8_WAIT_L(0); PG8_BAR; PG8_MMA(1, 0, At, B0); PG8_MMA(1, 1, At, B1); PG8_BAR; PG8_SCHED;
            PG8_LDB(B0, 1, 0); PG8_LDB(B1, 1, 1); PG8_SCHED; PG8_LDA(At, 1, 0); PG8_STAGE(PG8_SA(0, 1), a2 + hstep, voffA);
            PG8_WAIT_V(8); PG8_WAIT_L(0); PG8_BAR; PG8_MMA(0, 0, At, B0); PG8_MMA(0, 1, At, B1); PG8_BAR; PG8_SCHED;
            PG8_LDA(At, 1, 1); PG8_STAGE(PG8_SB(1, 0), b3, voffB); PG8_STAGE(PG8_SB(1, 1), b3 + hstep, voffB); PG8_STAGE(PG8_SA(1, 0), a3, voffA);
            PG8_WAIT_V(8); PG8_WAIT_L(0); PG8_BAR; PG8_MMA(1, 0, At, B0); PG8_MMA(1, 1, At, B1); PG8_BAR; PG8_SCHED;
            } else {
            PG8_LDB(B0, 0, 0); PG8_SCHED; PG8_LDA(At, 0, 0); PG8_STAGE(PG8_SA(1, 1), a1 + hstep, voffA);
            PG8_WAIT_L(8); PG8_BAR; PG8_WAIT_L(0); PG8_MMA(0, 0, At, B0); PG8_BAR; PG8_SCHED;
            PG8_LDB(B1, 0, 1); PG8_STAGE(PG8_SB(0, 0), b2, voffB);
            PG8_BAR; PG8_WAIT_L(0); PG8_MMA(0, 1, At, B1); PG8_BAR;
            PG8_LDA(At, 0, 1); PG8_STAGE(PG8_SA(0, 0), a2, voffA);
            PG8_BAR; PG8_WAIT_L(0); PG8_MMA(1, 0, At, B0); PG8_BAR; PG8_SCHED;
            PG8_STAGE(PG8_SB(0, 1), b2 + hstep, voffB);
            PG8_WAIT_V(6); PG8_BAR; PG8_MMA(1, 1, At, B1); PG8_BAR;
            PG8_LDB(B0, 1, 0); PG8_SCHED; PG8_LDA(At, 1, 0); PG8_STAGE(PG8_SA(0, 1), a2 + hstep, voffA);
            PG8_WAIT_L(8); PG8_BAR; PG8_WAIT_L(0); PG8_MMA(0, 0, At, B0); PG8_BAR; PG8_SCHED;
            PG8_LDB(B1, 1, 1); PG8_STAGE(PG8_SB(1, 0), b3, voffB);
            PG8_BAR; PG8_WAIT_L(0); PG8_MMA(0, 1, At, B1); PG8_BAR;
            PG8_LDA(At, 1, 1); PG8_STAGE(PG8_SA(1, 0), a3, voffA);
            PG8_BAR; PG8_WAIT_L(0); PG8_MMA(1, 0, At, B0); PG8_BAR; PG8_SCHED;
            PG8_STAGE(PG8_SB(1, 1), b3 + hstep, voffB);
            PG8_WAIT_V(6); PG8_BAR; PG8_MMA(1, 1, At, B1); PG8_BAR;
            }
        }
        if constexpr (ALIGN_EPI) { if (wr == 0) PG8_BAR; }
        if constexpr (!Epi::AFTER_DRAIN) { E(acc, cur, wr, wc, fr, fq); S.done(cur); }
        if (!has_next) break;
#pragma unroll
        for (int a = 0; a < 2; ++a)
#pragma unroll
            for (int b = 0; b < 2; ++b)
#pragma unroll
                for (int m = 0; m < 4; ++m)
#pragma unroll
                    for (int n = 0; n < 2; ++n) acc[a][b][m][n] = (f32x4){0.f, 0.f, 0.f, 0.f};
        cur = nxt; cA = nA; cB = nB; ++ui;
        if constexpr (ALIGN_EPI) { if (wr == 1) PG8_BAR; }
    }
    PG8_WAIT_V(0);
    if constexpr (!ALIGN_EPI) { if (wr == 0) PG8_BAR; }
    PG8_BAR;
    if constexpr (Epi::AFTER_DRAIN) { E.fused(acc, cur, wr, wc, fr, fq, lds, wid, lane); S.done(cur); }
#undef PG8_SA
#undef PG8_SB
#undef PG8_STAGE
#undef PG8_LDA
#undef PG8_LDB
#undef PG8_MMA
#undef PG8_WAIT_V
#undef PG8_WAIT_L
#undef PG8_BAR
#undef PG8_SCHED
}
}
#include <hip/hip_bf16.h>
#include <cmath>
namespace attn_body {
using bf16=__hip_bfloat16;
using bf16x8=__attribute__((ext_vector_type(8)))short;
using s16x4=__attribute__((ext_vector_type(4)))short;
using f32x16=__attribute__((ext_vector_type(16)))float;
using u32x4=__attribute__((ext_vector_type(4)))unsigned;
constexpr int BATCH=4,NHEAD=8,SEQ=4096,D=64,DM=12288,OPITCH=2048;
constexpr int NW=8,QBLK=32,QB=QBLK*NW,KVBLK=64,NQB=SEQ/QB;
constexpr int ATTN_PITCH=DM, ATTN_UNIT_ROWS=QB;
__device__ __forceinline__ int crow(int r,int hi){return (r&3)+8*(r>>2)+4*hi;}
#define SBAR() __builtin_amdgcn_sched_barrier(0)
__device__ __forceinline__ void cmask(f32x16&p0,f32x16&p1,int jb,int qrel,int hi){
  const float NEG=-INFINITY; int kb=64*jb+4*hi;
  #pragma unroll
  for(int r=0;r<16;++r){int kv=kb+(r&3)+8*(r>>2); if(kv>qrel)p0[r]=NEG; if(kv+32>qrel)p1[r]=NEG;}
}

constexpr int NSLOT=3, SLOTB=8192;
constexpr int LDS_K=0, LDS_V=NSLOT*SLOTB, LDS_WS=2*NSLOT*SLOTB, LDS_OST=LDS_WS+NW*64*4, LDS_BYTES=LDS_OST+NW*4096;
constexpr float C2=0.125f*1.4426950408889634f;
__device__ __forceinline__ void glds16(const void*gsrc,unsigned lds_dst){unsigned keep;
  asm volatile("s_mov_b32 %0, m0\n\ts_mov_b32 m0, %2\n\ts_nop 0\n\tglobal_load_lds_dwordx4 %1, off\n\ts_mov_b32 m0, %0":"=&s"(keep):"v"(gsrc),"s"(lds_dst):"memory");}
__device__ __forceinline__ float max3f(float a,float b,float c){float r;asm("v_max3_f32 %0, %1, %2, %3":"=v"(r):"v"(a),"v"(b),"v"(c));return r;}
__device__ __forceinline__ float max2f(float a,float b){float r;asm("v_max_f32_e32 %0, %1, %2":"=v"(r):"v"(a),"v"(b));return r;}
__device__ __forceinline__ float fadd_s(float a,float b){float r;asm("v_add_f32_e32 %0, %1, %2":"=v"(r):"v"(a),"v"(b));return r;}
__device__ __forceinline__ float fsub_s(float a,float b){float r;asm("v_sub_f32_e32 %0, %1, %2":"=v"(r):"v"(a),"v"(b));return r;}
typedef float f32x2_t __attribute__((ext_vector_type(2))); typedef __bf16 bf16x2_t __attribute__((ext_vector_type(2)));
__device__ __forceinline__ unsigned cvtpk_s(float lo,float hi){f32x2_t v={lo,hi};bf16x2_t b=__builtin_convertvector(v,bf16x2_t);return __builtin_bit_cast(unsigned,b);}
#define WAIT_BAR(N) asm volatile("s_waitcnt vmcnt(" #N ") lgkmcnt(0)\n\ts_barrier":::"memory")
typedef float f32x4_t __attribute__((ext_vector_type(4)));
typedef const __attribute__((address_space(3))) f32x4_t* lds_f4p;
#define CBIAS(P0,P1,t) do{ lds_f4p cp_=cb4+16*(t)+hi; _Pragma("unroll") for(int g_=0;g_<4;++g_){ const f32x4_t b0_=cp_[2*g_], b1_=cp_[2*g_+8]; P0[4*g_]+=b0_[0];P0[4*g_+1]+=b0_[1];P0[4*g_+2]+=b0_[2];P0[4*g_+3]+=b0_[3]; P1[4*g_]+=b1_[0];P1[4*g_+1]+=b1_[1];P1[4*g_+2]+=b1_[2];P1[4*g_+3]+=b1_[3]; } }while(0)

__device__ __forceinline__ void qkt(f32x16&p0,f32x16&p1,const char*Kslot,const bf16x8*qr,const f32x16&negm,int r32,int hi){
  const char*kb=Kslot+hi*1024+r32*16;
  #pragma unroll
  for(int d0=0;d0<4;++d0){
    const bf16x8 b0=*reinterpret_cast<const bf16x8*>(kb+d0*2048);
    const bf16x8 b1=*reinterpret_cast<const bf16x8*>(kb+d0*2048+512);
    if(d0==0){p0=__builtin_amdgcn_mfma_f32_32x32x16_bf16(b0,qr[0],negm,0,0,0);p1=__builtin_amdgcn_mfma_f32_32x32x16_bf16(b1,qr[0],negm,0,0,0);}
    else{p0=__builtin_amdgcn_mfma_f32_32x32x16_bf16(b0,qr[d0],p0,0,0,0);p1=__builtin_amdgcn_mfma_f32_32x32x16_bf16(b1,qr[d0],p1,0,0,0);}}
}
typedef __attribute__((address_space(3))) const char* lds_cptr;
typedef short v4i16_t __attribute__((ext_vector_type(4)));
__device__ __forceinline__ void kload8(bf16x8*kf,lds_cptr kp){
  kf[0]=*(const __attribute__((address_space(3))) bf16x8*)(kp);      kf[1]=*(const __attribute__((address_space(3))) bf16x8*)(kp+512);
  kf[2]=*(const __attribute__((address_space(3))) bf16x8*)(kp+2048); kf[3]=*(const __attribute__((address_space(3))) bf16x8*)(kp+2560);
  kf[4]=*(const __attribute__((address_space(3))) bf16x8*)(kp+4096); kf[5]=*(const __attribute__((address_space(3))) bf16x8*)(kp+4608);
  kf[6]=*(const __attribute__((address_space(3))) bf16x8*)(kp+6144); kf[7]=*(const __attribute__((address_space(3))) bf16x8*)(kp+6656);
}
__device__ __forceinline__ void kload2(bf16x8*kf,lds_cptr kp,int j){ kf[2*j]=*(const __attribute__((address_space(3))) bf16x8*)(kp+j*2048); kf[2*j+1]=*(const __attribute__((address_space(3))) bf16x8*)(kp+j*2048+512); }
__device__ __forceinline__ s16x4 vtr(lds_cptr p){ return __builtin_bit_cast(s16x4,__builtin_amdgcn_ds_read_tr16_b64_v4i16((__attribute__((address_space(3))) v4i16_t*)p)); }
__device__ __forceinline__ float rowmax(const f32x16&p0,const f32x16&p1){
  float a=max3f(p0[0],p0[1],p1[0]),b=max3f(p0[2],p0[3],p1[1]);a=max3f(a,p1[2],p1[3]);
  #pragma unroll
  for(int r=4;r<16;r+=4){a=max3f(a,p0[r],p0[r+1]);b=max3f(b,p0[r+2],p0[r+3]);a=max3f(a,p1[r],p1[r+1]);b=max3f(b,p1[r+2],p1[r+3]);}
  const float m=max2f(a,b);
  auto rr=__builtin_amdgcn_permlane32_swap(__float_as_uint(m),__float_as_uint(m),false,false);
  return max2f(__uint_as_float(rr[0]),__uint_as_float(rr[1]));
}
__device__ __forceinline__ void pv(f32x16*o,int vb,bf16x8 pa0,bf16x8 pa1,bf16x8 pa2,bf16x8 pa3){
  #pragma unroll
  for(int d0=0;d0<2;++d0){s16x4 lo[4],hi[4];
    #pragma unroll
    for(int ks=0;ks<4;++ks){
      asm volatile("ds_read_b64_tr_b16 %0,%1 offset:%c2":"=&v"(lo[ks]):"v"(vb),"i"(d0*4096+ks*1024):"memory");
      asm volatile("ds_read_b64_tr_b16 %0,%1 offset:%c2":"=&v"(hi[ks]):"v"(vb),"i"(d0*4096+ks*1024+512):"memory");}
    asm volatile("s_waitcnt lgkmcnt(0)":::"memory");SBAR();
    #define PK(k) (bf16x8){lo[k][0],lo[k][1],lo[k][2],lo[k][3],hi[k][0],hi[k][1],hi[k][2],hi[k][3]}
    o[d0]=__builtin_amdgcn_mfma_f32_32x32x16_bf16(pa0,PK(0),o[d0],0,0,0);
    o[d0]=__builtin_amdgcn_mfma_f32_32x32x16_bf16(pa1,PK(1),o[d0],0,0,0);
    o[d0]=__builtin_amdgcn_mfma_f32_32x32x16_bf16(pa2,PK(2),o[d0],0,0,0);
    o[d0]=__builtin_amdgcn_mfma_f32_32x32x16_bf16(pa3,PK(3),o[d0],0,0,0);
    #undef PK
  }
}

#ifndef ATTN_STORE16
#define ATTN_STORE16(p,v) (*(u32x4*)(p)=(v))
#endif
template<int THRL> __device__ __forceinline__ void attn_unit(int b,int h,int qb,const bf16*Q,const bf16*__restrict__ K,const bf16*__restrict__ V,bf16*O,const bf16*__restrict__ G,lds_f4p cb4_in,int T0,char*shm){
  int tid_=threadIdx.x; asm volatile("":"+v"(tid_)); const int tid=tid_,lane=tid&63,r32=lane&31,hi=lane>>5; const int wid=__builtin_amdgcn_readfirstlane(tid>>6);
  const long rowbase=(long)b*SEQ; const int q0=qb*QB; const lds_f4p cb4=cb4_in+16*T0; const __attribute__((address_space(3))) float* cbs=(const __attribute__((address_space(3))) float*)cb4;
  const bf16*Qw=Q+(rowbase+q0+wid*QBLK)*DM+h*D;
  const bf16*Kh=K+(rowbase+(long)T0*KVBLK)*DM+h*D,*Vh=V+(rowbase+(long)T0*KVBLK)*DM+h*D;
  const unsigned lds0=(unsigned)(uintptr_t)shm;
  float*wsf=(float*)(shm+LDS_WS)+wid*64;
  const bf16*ksrc=Kh+(long)lane*DM+wid*8;
  const bf16*vsrc=Vh+(long)(16*(wid&3)+(lane>>2))*DM+(wid>>2)*32+(lane&3)*8;
  const unsigned kdst=lds0+LDS_K+wid*1024, vdst=lds0+LDS_V+wid*1024;
  #define DMA_K(t,slot) glds16(ksrc+(long)(t)*KVBLK*DM,(unsigned)__builtin_amdgcn_readfirstlane(kdst+(slot)))
  #define DMA_V(t,slot) glds16(vsrc+(long)(t)*KVBLK*DM,(unsigned)__builtin_amdgcn_readfirstlane(vdst+(slot)))
  const int vb0=(int)(lds0+LDS_V)+((lane>>4)&1)*32+(lane&3)*8+(4*hi+((lane&15)>>2))*64;
  const char*Kbase=shm+LDS_K; bf16x8 kf[8];
  const lds_cptr shm3=(lds_cptr)shm; const lds_cptr kp0=shm3+LDS_K+hi*1024+r32*16; const lds_cptr vp0=shm3+LDS_V+((lane>>4)&1)*32+(lane&3)*8+(4*hi+((lane&15)>>2))*64;
  const int NT=(q0+QB)/KVBLK-T0;
  DMA_K(0,0);DMA_V(0,0);DMA_K(1,SLOTB);
  bf16x8 qr[4];
  #pragma unroll
  for(int d0=0;d0<4;++d0)qr[d0]=*reinterpret_cast<const bf16x8*>(&Qw[(long)r32*DM+d0*16+hi*8]);
  float mhat=0.f,l_reg=0.f;f32x16 o[2];o[0]=f32x16{};o[1]=f32x16{};f32x16 negm=f32x16{};asm volatile("":"+v"(negm));
  const int qrel=wid*QBLK+r32;
  #define CMASK(P0,P1,t) do{int jb_=(t)-(NT-4); if(jb_>=0)cmask(P0,P1,jb_,qrel,hi);}while(0)
  bool resc=false;
  #define START(P0,P1) do{ const float rm=rowmax(P0,P1); resc=false; \
    { const float dl=rm; mhat=fadd_s(mhat,dl); \
      _Pragma("unroll") for(int r=0;r<16;++r){P0[r]=fsub_s(P0[r],dl);P1[r]=fsub_s(P1[r],dl);} \
      _Pragma("unroll") for(int r=0;r<16;++r)negm[r]=-mhat; asm volatile("":"+v"(negm)); } \
    _Pragma("unroll") for(int r=0;r<16;++r)P0[r]=__builtin_amdgcn_exp2f(P0[r]); }while(0)
  #define RESC() do{ if(resc){ asm volatile("s_waitcnt lgkmcnt(0)":::"memory"); \
      _Pragma("unroll") for(int d_=0;d_<2;++d_) _Pragma("unroll") for(int r=0;r<16;++r)o[d_][r]*=wsf[crow(r,hi)]; } }while(0)
  f32x16 pA0,pA1,pB0,pB1;
  int sl_prev=0,sl_cur=0,sl_next=SLOTB;
  #define ROT() do{sl_prev=sl_cur;sl_cur=sl_next;sl_next=(sl_next==(NSLOT-1)*SLOTB)?0:sl_next+SLOTB;}while(0)
  DMA_K(2,2*SLOTB);
  WAIT_BAR(3);
  qkt(pA0,pA1,Kbase,qr,negm,r32,hi);asm volatile("s_nop 15\n\ts_nop 7":"+v"(pA0),"+v"(pA1));CBIAS(pA0,pA1,0);CMASK(pA0,pA1,0);
  START(pA0,pA1);
  _Pragma("unroll") for(int r=0;r<16;++r)pA1[r]=__builtin_amdgcn_exp2f(pA1[r]);
  WAIT_BAR(0);
  DMA_K(3,0);DMA_V(1,SLOTB);
  ROT();
  kload8(kf,kp0+sl_cur);
  WAIT_BAR(2);
  s16x4 vlo[8],vhi[8]; u32x4 pw0,pw1,pw2,pw3;
  #define PKW(P,B) cvtpk_s(P[B],P[B+1])
  #define PAF(k) __builtin_bit_cast(bf16x8,pw##k)
  #define VFR(i) (bf16x8){vlo[i][0],vlo[i][1],vlo[i][2],vlo[i][3],vhi[i][0],vhi[i][1],vhi[i][2],vhi[i][3]}
  #define PIN(x) asm volatile("":"+v"(x))
  #define MX3(a,b,c) __builtin_fmaxf(__builtin_fmaxf((a),(b)),(c))
  #define GAPA(MF,A0,A1,A2,A3,W0,W1,PW) do{ MF; sacc+=A0; sacc+=A1; sacc+=A2; sacc+=A3; PIN(sacc); W0; W1; PIN(PW); SBAR(); }while(0)
  #define EX(v) __builtin_amdgcn_exp2f(v)
  #define GAPB(MF,X,B,NI) do{ const f32x4_t bc_=bnx_; bnx_=cp_[NI]; MF; X[B]=EX(X[B]+bc_[0]); X[B+1]=EX(X[B+1]+bc_[1]); X[B+2]=EX(X[B+2]+bc_[2]); X[B+3]=EX(X[B+3]+bc_[3]); PIN(X); SBAR(); }while(0)
  #define VRD(i) do{ vlo[i]=vtr(vp_+(((i)>>2)*4096+((i)&3)*1024)); vhi[i]=vtr(vp_+(((i)>>2)*4096+((i)&3)*1024+512)); }while(0)
  #define KRD(G,j) do{ if(G){ kload2(kf,kp0+sl_next,j); SBAR(); } }while(0)
  #define STEP(C0,C1,P0,P1,t,GK,GV,GL) do{ SBAR(); \
    const lds_cptr vp_=vp0+sl_prev; \
    VRD(0); SBAR(); float sacc=(P0[0]+P0[1]); \
    GAPA(C0=__builtin_amdgcn_mfma_f32_32x32x16_bf16(kf[0],qr[0],negm,0,0,0), P0[2],P0[3],P0[4],P0[5],     pw0[0]=PKW(P0,0), pw0[1]=PKW(P0,2), pw0); \
    VRD(4); SBAR(); GAPA(C1=__builtin_amdgcn_mfma_f32_32x32x16_bf16(kf[1],qr[0],negm,0,0,0), P0[6],P0[7],P0[8],P0[9],     pw0[2]=PKW(P0,4), pw0[3]=PKW(P0,6), pw0); \
    VRD(1); SBAR(); GAPA(C0=__builtin_amdgcn_mfma_f32_32x32x16_bf16(kf[2],qr[1],C0,0,0,0),   P0[10],P0[11],P0[12],P0[13], pw1[0]=PKW(P0,8), pw1[1]=PKW(P0,10), pw1); \
    VRD(5); SBAR(); GAPA(C1=__builtin_amdgcn_mfma_f32_32x32x16_bf16(kf[3],qr[1],C1,0,0,0),   P0[14],P0[15],P1[0],P1[1],   pw1[2]=PKW(P0,12),pw1[3]=PKW(P0,14), pw1); \
    VRD(2); SBAR(); GAPA(C0=__builtin_amdgcn_mfma_f32_32x32x16_bf16(kf[4],qr[2],C0,0,0,0),   P1[2],P1[3],P1[4],P1[5],     pw2[0]=PKW(P1,0), pw2[1]=PKW(P1,2), pw2); \
    VRD(6); SBAR(); GAPA(C1=__builtin_amdgcn_mfma_f32_32x32x16_bf16(kf[5],qr[2],C1,0,0,0),   P1[6],P1[7],P1[8],P1[9],     pw2[2]=PKW(P1,4), pw2[3]=PKW(P1,6), pw2); \
    VRD(3); SBAR(); GAPA(C0=__builtin_amdgcn_mfma_f32_32x32x16_bf16(kf[6],qr[3],C0,0,0,0),   P1[10],P1[11],P1[12],P1[13], pw3[0]=PKW(P1,8), pw3[1]=PKW(P1,10), pw3); \
    VRD(7); SBAR(); GAPA(C1=__builtin_amdgcn_mfma_f32_32x32x16_bf16(kf[7],qr[3],C1,0,0,0),   P1[14],P1[15],0.f,0.f,       pw3[2]=PKW(P1,12),pw3[3]=PKW(P1,14), pw3); \
    l_reg+=sacc; \
    if(GK){DMA_K((t)+3,sl_cur);} if(GV){DMA_V((t)+1,sl_next);} \
    CMASK(C0,C1,t); \
    { float a=MX3(C0[0],C0[1],C1[0]),b=MX3(C0[2],C0[3],C1[1]); a=MX3(a,C1[2],C1[3]); \
      _Pragma("unroll") for(int r=4;r<16;r+=4){a=MX3(a,C0[r],C0[r+1]);b=MX3(b,C0[r+2],C0[r+3]);a=MX3(a,C1[r],C1[r+1]);b=MX3(b,C1[r+2],C1[r+3]);} \
      float rm=__builtin_fmaxf(a,b); { auto rr=__builtin_amdgcn_permlane32_swap(__float_as_uint(rm),__float_as_uint(rm),false,false); rm=__builtin_fmaxf(__uint_as_float(rr[0]),__uint_as_float(rr[1])); } \
      rm+=cbs[64*(t)+63]; resc=false; \
      if(__builtin_expect(__any(rm>(float)THRL),0)){ const float dl=__builtin_fmaxf(rm,0.f); mhat+=dl; \
        _Pragma("unroll") for(int r=0;r<16;++r){C0[r]-=dl;C1[r]-=dl;} \
        _Pragma("unroll") for(int r=0;r<16;++r)negm[r]=-mhat; asm volatile("":"+v"(negm)); \
        const float f=__builtin_amdgcn_exp2f(-dl); l_reg*=f; if(hi==0)wsf[r32]=f; resc=true; } } \
    lds_f4p cp_=cb4+16*(t)+hi; f32x4_t bnx_=cp_[0]; SBAR(); \
    GAPB(o[0]=__builtin_amdgcn_mfma_f32_32x32x16_bf16(PAF(0),VFR(0),o[0],0,0,0), C0,0,2); \
    GAPB(o[1]=__builtin_amdgcn_mfma_f32_32x32x16_bf16(PAF(0),VFR(4),o[1],0,0,0), C0,4,4); \
    KRD(GL,0); GAPB(o[0]=__builtin_amdgcn_mfma_f32_32x32x16_bf16(PAF(1),VFR(1),o[0],0,0,0), C0,8,6); \
    KRD(GL,1); GAPB(o[1]=__builtin_amdgcn_mfma_f32_32x32x16_bf16(PAF(1),VFR(5),o[1],0,0,0), C0,12,8); \
    KRD(GL,2); GAPB(o[0]=__builtin_amdgcn_mfma_f32_32x32x16_bf16(PAF(2),VFR(2),o[0],0,0,0), C1,0,10); \
    KRD(GL,3); GAPB(o[1]=__builtin_amdgcn_mfma_f32_32x32x16_bf16(PAF(2),VFR(6),o[1],0,0,0), C1,4,12); \
    GAPB(o[0]=__builtin_amdgcn_mfma_f32_32x32x16_bf16(PAF(3),VFR(3),o[0],0,0,0), C1,8,14); \
    GAPB(o[1]=__builtin_amdgcn_mfma_f32_32x32x16_bf16(PAF(3),VFR(7),o[1],0,0,0), C1,12,14); \
    }while(0)
  int t=1;
  #undef CMASK
  #define CMASK(P0,P1,t) do{}while(0)
  for(;t+5<NT;t+=2){
    STEP(pB0,pB1,pA0,pA1,t,true,true,true);     WAIT_BAR(2); RESC(); ROT();
    STEP(pA0,pA1,pB0,pB1,t+1,true,true,true);   WAIT_BAR(2); RESC(); ROT();
  }
  #undef CMASK
  #define CMASK(P0,P1,t) do{int jb_=(t)-(NT-4); if(jb_>=0)cmask(P0,P1,jb_,qrel,hi);}while(0)
  #define ENDW(tt) do{ if((tt)+3<NT){WAIT_BAR(2);} else if((tt)+2<NT){WAIT_BAR(1);} else {WAIT_BAR(0);} }while(0)
  for(;t+1<NT;t+=2){
    STEP(pB0,pB1,pA0,pA1,t,(t+3<NT),(t+1<NT),(t+1<NT));       ENDW(t);   RESC(); ROT();
    STEP(pA0,pA1,pB0,pB1,t+1,(t+4<NT),(t+2<NT),(t+2<NT));     ENDW(t+1); RESC(); ROT();
  }
  STEP(pB0,pB1,pA0,pA1,NT-1,false,false,false); RESC();
  { float sacc=pB0[0]+pB0[1]; _Pragma("unroll") for(int r=2;r<16;++r)sacc+=pB0[r]; _Pragma("unroll") for(int r=0;r<16;++r)sacc+=pB1[r]; l_reg+=sacc;
    pw0=(u32x4){PKW(pB0,0),PKW(pB0,2),PKW(pB0,4),PKW(pB0,6)};pw1=(u32x4){PKW(pB0,8),PKW(pB0,10),PKW(pB0,12),PKW(pB0,14)};pw2=(u32x4){PKW(pB1,0),PKW(pB1,2),PKW(pB1,4),PKW(pB1,6)};pw3=(u32x4){PKW(pB1,8),PKW(pB1,10),PKW(pB1,12),PKW(pB1,14)};
    SBAR(); pv(o,vb0+sl_cur,PAF(0),PAF(1),PAF(2),PAF(3)); }
  #undef PKW
  #undef PAF
  #undef VFR
  #undef PIN
  #undef MX3
  #undef GAPA
  #undef GAPB
  #undef EX
  #undef VRD
  #undef KRD
  #undef STEP
  #undef ENDW
  {auto rr=__builtin_amdgcn_permlane32_swap(__float_as_uint(l_reg),__float_as_uint(l_reg),false,false);l_reg=__uint_as_float(rr[0])+__uint_as_float(rr[1]);}
  if(hi==0)wsf[32+r32]=l_reg;asm volatile("s_waitcnt lgkmcnt(0)":::"memory");
  float rli[16];
  #pragma unroll
  for(int r=0;r<16;++r)rli[r]=__builtin_amdgcn_rcpf(wsf[32+crow(r,hi)]);
  bf16*Ow=O+(rowbase+q0+wid*QBLK)*OPITCH+h*D; const bf16*Gw=G+(rowbase+q0+wid*QBLK)*DM+h*D;
  { bf16*stg=(bf16*)(shm+LDS_OST)+wid*2048;
    #pragma unroll
    for(int r=0;r<16;++r){const int orow=crow(r,hi);
      #pragma unroll
      for(int d0=0;d0<2;++d0)stg[orow*64+d0*32+r32]=__float2bfloat16(o[d0][r]*rli[r]);}
    asm volatile("s_waitcnt lgkmcnt(0)":::"memory");
    #pragma unroll
    for(int i=0;i<4;++i){const int row=i*8+(lane>>3),ch=lane&7; u32x4 v=*(const u32x4*)(stg+row*64+ch*8); const u32x4 gg=*(const u32x4*)(Gw+(long)row*DM+ch*8);
      _Pragma("unroll") for(int e_=0;e_<4;++e_){ const float a0=__uint_as_float(v[e_]<<16)*__uint_as_float(gg[e_]<<16), a1=__uint_as_float(v[e_]&0xffff0000u)*__uint_as_float(gg[e_]&0xffff0000u); v[e_]=cvtpk_s(a0,a1); }
      ATTN_STORE16(Ow+(long)row*OPITCH+ch*8,v);} }
  asm volatile("s_waitcnt lgkmcnt(0)\n\ts_barrier":::"memory");
  #undef DMA_K
  #undef DMA_V
  #undef CMASK
  #undef START
  #undef RESC
  #undef ROT
}
constexpr int ATTN_LDS_BYTES=LDS_BYTES;
#undef SBAR
#undef WAIT_BAR
}
#define LAS __attribute__((address_space(3)))
typedef unsigned short bf16;
typedef unsigned v4u __attribute__((ext_vector_type(4)));
typedef unsigned v2u __attribute__((ext_vector_type(2)));
typedef float f32x4 __attribute__((ext_vector_type(4)));
typedef short bf16x8 __attribute__((ext_vector_type(8)));
typedef short s16x4 __attribute__((ext_vector_type(4)));
using pg8::bf_lo; using pg8::bf_hi;
constexpr int NWAVES = 8, NTHR = 512;
constexpr int BATCH = 4, SEQ = 4096, DM = 2048, T = BATCH * SEQ, DEPTH = 2, MEMLEN = 256, MROWS = BATCH * MEMLEN;
constexpr int INC = 12312, NZ = 12544, ZP = 12288;
constexpr int ZC_GQ = 0, ZC_GK = 512, ZC_GV = 1024, ZC_GG = 2048, ZC_FQ = 3072, ZC_FK = 3584, ZC_FV = 4096, ZC_FG = 4608, ZC_MQ = 5120, ZC_MG = 5632, ZC_MERGE = 6144;
constexpr size_t MiB = 1u << 20;
constexpr size_t WS_WIN = 0, WS_WBR = 98 * MiB, WS_WOUT = 114 * MiB, WS_WKV = 130 * MiB, WS_XB = 138 * MiB, WS_Y = 202 * MiB, WS_U = 266 * MiB, WS_Z = 330 * MiB,
                 WS_ZS = 714 * MiB, WS_MEMB = 716 * MiB, WS_MKV = 720 * MiB, WS_DV = 724 * MiB, WS_SS = 725 * MiB, WS_CTL = 726 * MiB, WS_FOXT = 727 * MiB, WS_END = 728 * MiB;
constexpr int FT_CBL = 0, FT_SEG = 32 * 4096, FT_QNB = FT_SEG + 32 * 8, FT_KNS = FT_QNB + 32 * 16;
constexpr size_t CTL_ZERO_BYTES = 65536;
constexpr int LDS_BYTES = 155648;

typedef float f32x2c_t __attribute__((ext_vector_type(2))); typedef __bf16 bf16x2c_t __attribute__((ext_vector_type(2)));
__device__ __forceinline__ unsigned pk2(float lo, float hi) { const f32x2c_t v = {lo, hi}; return __builtin_bit_cast(unsigned, __builtin_convertvector(v, bf16x2c_t)); }
__device__ __forceinline__ unsigned f2bf(float f) { return pk2(f, 0.f) & 0xffffu; }
__device__ __forceinline__ float bf2f(bf16 v) { return __uint_as_float(((unsigned)v) << 16); }
__device__ __forceinline__ float wave_sum(float v) {
#pragma unroll
    for (int o = 1; o < 64; o <<= 1) v += __shfl_xor(v, o);
    return v;
}
__device__ __forceinline__ float logsig(float x) { return fminf(x, 0.f) - __logf(1.f + __expf(-fabsf(x))); }
#define DPP_ADD(v, ctrl) ((v) + __builtin_bit_cast(float, __builtin_amdgcn_update_dpp(0, __builtin_bit_cast(int, (v)), (ctrl), 0xF, 0xF, true)))
__device__ __forceinline__ float row16_sum(float v) { v = DPP_ADD(v, 0xB1); v = DPP_ADD(v, 0x4E); v = DPP_ADD(v, 0x141); v = DPP_ADD(v, 0x140); return v; }
#define MFMA16(a, b, c) __builtin_amdgcn_mfma_f32_16x16x32_bf16((a), (b), (c), 0, 0, 0)
__device__ __forceinline__ s16x4 trread(const LAS unsigned char* p) { return __builtin_bit_cast(s16x4, __builtin_amdgcn_ds_read_tr16_b64_v4i16((LAS s16x4*)p)); }
__device__ __forceinline__ bf16x8 cat8(s16x4 lo, s16x4 hi) { return (bf16x8){lo[0], lo[1], lo[2], lo[3], hi[0], hi[1], hi[2], hi[3]}; }

#define GAS __attribute__((address_space(1)))
#define XB_TMO      128
#define XB_XCNT(j)  (256  + 64 * (j))
#define XB_XSUB(j)  (1280 + 64 * (j))
#define XB_XGEN(j)  (2304 + 64 * (j))
#define XB_TOP      3328
#define XB_TOPGEN   3392
#define XCD_BAR_WORDS 3456
#define XB_SPIN_CAP (1u << 18)

__device__ __forceinline__ unsigned xb_ld(unsigned* p)              { return __hip_atomic_load(p, __ATOMIC_RELAXED, __HIP_MEMORY_SCOPE_AGENT); }
__device__ __forceinline__ unsigned xb_add(unsigned* p, unsigned v) { return __hip_atomic_fetch_add(p, v, __ATOMIC_RELAXED, __HIP_MEMORY_SCOPE_AGENT); }
__device__ __forceinline__ unsigned xb_xcc_id() { return (unsigned)__builtin_amdgcn_s_getreg((3 << 11) | 20) & 0xFu; }
#define XB_SPIN(cond, bar) do { unsigned _sp = 0; while (cond) { __builtin_amdgcn_s_sleep(1); \
    if ((++_sp & 255u) == 0u) { if (xb_ld(&(bar)[XB_TMO])) break; if (_sp > XB_SPIN_CAP) { atomicAdd(&(bar)[XB_TMO], 1u); break; } } } } while (0)

struct XcdBarrier {
    unsigned* bar; unsigned x;
    volatile LAS unsigned* st;
};

__device__ __forceinline__ XcdBarrier xcd_barrier_post(unsigned* bar, volatile LAS unsigned* st) {
    XcdBarrier b; b.bar = bar; b.x = xb_xcc_id(); b.st = st;
    if (threadIdx.x == 0) (void)xb_add(&bar[XB_XCNT(b.x)], 1u);
    return b;
}
__device__ __forceinline__ void xcd_barrier_complete(unsigned* bar, unsigned x, unsigned& nloc, unsigned& nx) {
    const unsigned G = gridDim.x * gridDim.y * gridDim.z;
    unsigned sum, cnt, mine, sp = 0u;
    for (;;) {
        sum = 0u; cnt = 0u; mine = 0u;
#pragma unroll
        for (unsigned j = 0; j < 16; ++j) { const unsigned c = xb_ld(&bar[XB_XCNT(j)]); sum += c; cnt += (c > 0u) ? 1u : 0u; mine = (j == x) ? c : mine; }
        if (sum == G) break;
        __builtin_amdgcn_s_sleep(1);
        if ((++sp & 255u) == 0u) { if (xb_ld(&bar[XB_TMO])) break; if (sp > XB_SPIN_CAP) { atomicAdd(&bar[XB_TMO], 1u); break; } }
    }
    nloc = mine > 0u ? mine : 1u; nx = cnt > 0u ? cnt : 1u;
}

__device__ __forceinline__ void xcd_barrier(const XcdBarrier& b) {
    asm volatile("s_waitcnt vmcnt(0)" ::: "memory");
    __syncthreads();
    if (threadIdx.x == 0) {
        unsigned* bar = b.bar; asm volatile("" : "+s"(bar));
        const unsigned bx_ = xb_xcc_id();
        __builtin_amdgcn_s_waitcnt(0);
        unsigned nloc = b.st[0], nx = b.st[1];
        if (nloc == 0u) { xcd_barrier_complete(bar, bx_, nloc, nx); b.st[0] = nloc; b.st[1] = nx; }
        const unsigned old = xb_add(&bar[XB_XSUB(bx_)], 1u);
        const unsigned gen = old / nloc;
        if (old + 1u == (gen + 1u) * nloc) {
            __builtin_amdgcn_fence(__ATOMIC_RELEASE, "agent");
            asm volatile("s_waitcnt vmcnt(0)" ::: "memory");
            const unsigned og = xb_add(&bar[XB_TOP], 1u);
            const unsigned tg = og / nx;
            if (og + 1u == (tg + 1u) * nx) xb_add(&bar[XB_TOPGEN], 1u);
            else XB_SPIN(xb_ld(&bar[XB_TOPGEN]) == tg, bar);
            __builtin_amdgcn_fence(__ATOMIC_ACQUIRE, "agent");
            xb_add(&bar[XB_XGEN(bx_)], 1u);
            asm volatile("s_waitcnt vmcnt(0)" ::: "memory");
        } else {
            XB_SPIN(xb_ld(&bar[XB_XGEN(bx_)]) == gen, bar);
            __builtin_amdgcn_fence(__ATOMIC_ACQUIRE, "agent");
            asm volatile("s_waitcnt vmcnt(0)" ::: "memory");
        }
    }
    __syncthreads();
}


struct Params {
    const float *x, *mem, *norm_gain, *w_in, *w_gk_up, *b_gk, *gla_norm_gain, *b_f, *mem_norm_gain, *w_mem_kv, *w_branch, *w_out, *final_gain;
    float* out; unsigned char* ws;
};

__device__ __forceinline__ int win_src_col(int n) {
    if (n < 3072) return n;
    if (n < 4608) return n + 16;
    if (n < 12288) return n + 24;
    if (n < 12304) return 3072 + (n - 12288);
    if (n < 12312) return 4624 + (n - 12304);
    return -1;
}
__device__ __forceinline__ void transpose_item(const float* W, int Nsrc, const float* gain, int kind, bf16* WT, int item, int nblk, int lane) {
    const int kb = item / nblk, nb = item % nblk, k0 = 64 * kb, nn = 64 * nb + lane;
    const int sc = kind == 0 ? win_src_col(nn) : nn;
    const float* src = W + (size_t)k0 * Nsrc + (sc >= 0 ? sc : 0);
    float v[64];
#pragma unroll
    for (int kk = 0; kk < 64; ++kk) v[kk] = src[(size_t)kk * Nsrc];
    if (gain) {
#pragma unroll
        for (int q = 0; q < 16; ++q) { const f32x4 g = *(const f32x4*)(gain + k0 + 4 * q); v[4 * q] *= g[0]; v[4 * q + 1] *= g[1]; v[4 * q + 2] *= g[2]; v[4 * q + 3] *= g[3]; } }
    if (sc < 0) {
#pragma unroll
        for (int kk = 0; kk < 64; ++kk) v[kk] = 0.f; }
    bf16* dst = WT + (size_t)nn * 2048 + k0;
#pragma unroll
    for (int c = 0; c < 8; ++c) { v4u o; o.x = pk2(v[8 * c], v[8 * c + 1]); o.y = pk2(v[8 * c + 2], v[8 * c + 3]); o.z = pk2(v[8 * c + 4], v[8 * c + 5]); o.w = pk2(v[8 * c + 6], v[8 * c + 7]); *(v4u*)(dst + 8 * c) = o; }
}
__device__ __forceinline__ void row_to_bf16(const float* xrow, bf16* orow, int lane) {
    const f32x4* xr = (const f32x4*)xrow + lane; float s = 0.f; v2u* o8 = (v2u*)orow + lane; f32x4 v[8];
#pragma unroll
    for (int j = 0; j < 8; ++j) { v[j] = xr[64 * j]; s += (v[j].x * v[j].x + v[j].y * v[j].y) + (v[j].z * v[j].z + v[j].w * v[j].w); }
    const float r = rsqrtf(wave_sum(s) * (1.0f / 2048.0f) + 1e-6f);
#pragma unroll
    for (int j = 0; j < 8; ++j) { v2u w; w.x = pk2(v[j].x * r, v[j].y * r); w.y = pk2(v[j].z * r, v[j].w * r); o8[64 * j] = w; }
}
__device__ __forceinline__ void rescale_rows(bf16* xb, const float* ssq, int tid, int G) {
    const int lane = tid & 63, wave = tid >> 6;
    for (int m = blockIdx.x * NWAVES + wave; m < T; m += G * NWAVES) { const float r = rsqrtf(ssq[m] * (1.0f / 2048.0f) + 1e-6f); v2u* o8 = (v2u*)(xb + (size_t)m * DM) + lane;
#pragma unroll
        for (int j = 0; j < 8; ++j) { v2u w = o8[64 * j]; w.x = pk2(bf_lo(w.x) * r, bf_hi(w.x) * r); w.y = pk2(bf_lo(w.y) * r, bf_hi(w.y) * r); o8[64 * j] = w; } }
}
__device__ __forceinline__ void phase_prologue(const Params& P, LAS unsigned char* lds, int tid, int G) {
    const int lane = tid & 63, wave = tid >> 6; const int gw = blockIdx.x * NWAVES + wave, NGW = G * NWAVES;
    unsigned char* ws = P.ws;
    constexpr int I_IN = 32 * (NZ / 64), I_BR = 32 * 32, I_OUT = 32 * 32, I_KV = 32 * 16, I_L = I_IN + I_BR + I_OUT + I_KV;
    for (int it = gw; it < DEPTH * I_L; it += NGW) {
        const int l = it / I_L; int r = it % I_L;
        if (r < I_IN) { transpose_item(P.w_in + (size_t)l * 2048 * INC, INC, P.norm_gain + l * 2048, 0, (bf16*)(ws + WS_WIN) + (size_t)l * NZ * 2048, r, NZ / 64, lane); continue; } r -= I_IN;
        if (r < I_BR) { transpose_item(P.w_branch + (size_t)l * 2048 * 2048, 2048, nullptr, 1, (bf16*)(ws + WS_WBR) + (size_t)l * 2048 * 2048, r, 32, lane); continue; } r -= I_BR;
        if (r < I_OUT) { transpose_item(P.w_out + (size_t)l * 2048 * 2048, 2048, nullptr, 1, (bf16*)(ws + WS_WOUT) + (size_t)l * 2048 * 2048, r, 32, lane); continue; } r -= I_OUT;
        transpose_item(P.w_mem_kv + (size_t)l * 2048 * 1024, 1024, P.mem_norm_gain + l * 2048, 1, (bf16*)(ws + WS_WKV) + (size_t)l * 1024 * 2048, r, 16, lane);
    }
    float* ss = (float*)(ws + WS_SS);
    for (int m = gw; m < T; m += NGW) row_to_bf16(P.x + (size_t)m * DM, (bf16*)(ws + WS_XB) + (size_t)m * DM, lane);
    for (int m = gw; m < MROWS; m += NGW) row_to_bf16(P.mem + (size_t)m * DM, (bf16*)(ws + WS_MEMB) + (size_t)m * DM, lane);
    for (int i = blockIdx.x * NTHR + tid; i < 2 * T; i += G * NTHR) ss[T + i] = 0.f;
}
__device__ __forceinline__ void gla_decay(LAS float* gd, LAS float* tot, int tid, const float (&w)[16], float bias, float (&bv)[16], float& blast) {
    const int d = tid & 127, rg = tid >> 7;
    float run = 0.f;
#pragma unroll
    for (int c = 0; c < 16; ++c) { const LAS f32x4* g4 = (const LAS f32x4*)(gd + (rg * 16 + c) * 16); float a = bias;
#pragma unroll
        for (int q = 0; q < 4; ++q) { const f32x4 g = g4[q]; a += g[0] * w[4 * q] + g[1] * w[4 * q + 1] + g[2] * w[4 * q + 2] + g[3] * w[4 * q + 3]; }
        run += logsig(a) * 0.0625f; bv[c] = run; }
    tot[rg * 128 + d] = run;
    __syncthreads();
    const float t0 = tot[d], t1 = tot[128 + d], t2 = tot[256 + d], t3 = tot[384 + d];
    const float off = (rg > 0 ? t0 : 0.f) + (rg > 1 ? t1 : 0.f) + (rg > 2 ? t2 : 0.f);
    blast = (t0 + t1) + (t2 + t3);
#pragma unroll
    for (int c = 0; c < 16; ++c) bv[c] += off;
}
__device__ __forceinline__ void load_v(const bf16* src, int tid, v4u (&r)[4]) {
#pragma unroll
    for (int i = 0; i < 4; ++i) { const int idx = tid + 512 * i, row = idx >> 5, ch = idx & 31; r[i] = *(const v4u*)(src + (size_t)row * ZP + ch * 8); }
}
__device__ __forceinline__ void store_v(LAS unsigned char* vt, int tid, const v4u (&r)[4]) {
#pragma unroll
    for (int i = 0; i < 4; ++i) { const int idx = tid + 512 * i, row = idx >> 5, ch = idx & 31; *(LAS v4u*)(vt + row * 544 + ch * 16) = r[i]; }
}
struct G1Pre { v4u vr[4]; };
__device__ __forceinline__ void gla_step1_pre(const Params& P, int item, int tid, G1Pre& R) {
    const int bh = item >> 6, n = item & 63, b = bh >> 2, h = bh & 3; const int t0 = b * SEQ + n * 64; const bf16* z = (const bf16*)(P.ws + WS_Z);
    load_v(z + (size_t)t0 * ZP + ZC_GV + h * 256, tid, R.vr);
}
__device__ __forceinline__ void gla_step1(const Params& P, int l, LAS unsigned char* lds, int item, int next_item, int tid, G1Pre& R) {
    const int bh = item >> 6, n = item & 63, b = bh >> 2, h = bh & 3; const int t0 = b * SEQ + n * 64;
    const bf16* z = (const bf16*)(P.ws + WS_Z); const float* zs = (const float*)(P.ws + WS_ZS);
    LAS unsigned char* KD = lds; LAS unsigned char* VT = lds + 18432; LAS float* GD = (LAS float*)(lds + 53248); LAS float* TOT = (LAS float*)(lds + 57344);
    const int d = tid & 127, rg = tid >> 7;
    f32x4 gdr = (f32x4){0.f, 0.f, 0.f, 0.f}; if (tid < 256) gdr = *(const f32x4*)(zs + (size_t)t0 * 32 + (tid >> 2) * 32 + (tid & 3) * 4);
    float wv[16]; { const float* wup = P.w_gk_up + (size_t)l * 16 * 512 + h * 128;
#pragma unroll
      for (int r = 0; r < 16; ++r) wv[r] = wup[r * 512 + d]; }
    const float bias = P.b_gk[l * 512 + h * 128 + d];
    bf16 kraw[16];
#pragma unroll
    for (int c = 0; c < 16; ++c) kraw[c] = z[(size_t)(t0 + rg * 16 + c) * ZP + ZC_GK + h * 128 + d];
    __syncthreads();
    if (tid < 256) *(LAS f32x4*)(GD + (tid >> 2) * 16 + (tid & 3) * 4) = gdr;
    store_v(VT, tid, R.vr);
    __syncthreads();
    float bv[16], blast;
    gla_decay(GD, TOT, tid, wv, bias, bv, blast);
    { unsigned pk[8];
#pragma unroll
      for (int c = 0; c < 16; c += 2) { const float k0 = bf2f(kraw[c]) * __expf(blast - bv[c]), k1 = bf2f(kraw[c + 1]) * __expf(blast - bv[c + 1]); pk[c >> 1] = pk2(k0, k1); }
      *(LAS v4u*)(KD + d * 144 + rg * 32) = (v4u){pk[0], pk[1], pk[2], pk[3]}; *(LAS v4u*)(KD + d * 144 + rg * 32 + 16) = (v4u){pk[4], pk[5], pk[6], pk[7]}; }
    if (rg == 0) ((float*)(P.ws + WS_DV))[(size_t)item * 128 + d] = __expf(blast);
    if (next_item >= 0) gla_step1_pre(P, next_item, tid, R);
    __syncthreads();
    const int lane = tid & 63, w = tid >> 6, i = lane & 15, quad = lane >> 4; const int e0 = w * 32;
    bf16x8 vf[2][2];
#pragma unroll
    for (int et = 0; et < 2; ++et)
#pragma unroll
        for (int ks = 0; ks < 2; ++ks) { const LAS unsigned char* p = VT + (ks * 32 + quad * 8 + (i >> 2)) * 544 + (e0 + et * 16 + 4 * (i & 3)) * 2; vf[et][ks] = cat8(trread(p), trread(p + 4 * 544)); }
    f32x4 acc[8][2];
#pragma unroll
    for (int dt = 0; dt < 8; ++dt) { acc[dt][0] = (f32x4){0.f, 0.f, 0.f, 0.f}; acc[dt][1] = (f32x4){0.f, 0.f, 0.f, 0.f};
#pragma unroll
        for (int ks = 0; ks < 2; ++ks) { const bf16x8 kf = *(const LAS bf16x8*)(KD + (dt * 16 + i) * 144 + (ks * 32 + quad * 8) * 2);
            acc[dt][0] = MFMA16(kf, vf[0][ks], acc[dt][0]); acc[dt][1] = MFMA16(kf, vf[1][ks], acc[dt][1]); } }
    bf16* Ut = (bf16*)(P.ws + WS_U) + (size_t)item * 256 * 128;
#pragma unroll
    for (int dt = 0; dt < 8; ++dt)
#pragma unroll
        for (int et = 0; et < 2; ++et) { const f32x4 a = acc[dt][et]; v2u o; o.x = pk2(a[0], a[1]); o.y = pk2(a[2], a[3]);
            *(v2u*)(Ut + (size_t)(e0 + et * 16 + i) * 128 + dt * 16 + quad * 4) = o; }
}
__device__ __forceinline__ void gla_scan(const Params& P, int tid, int cu, int ncu) {
    const bf16* Ut = (const bf16*)(P.ws + WS_U); bf16* St = (bf16*)(P.ws + WS_Y); const float* dv = (const float*)(P.ws + WS_DV);
    const int NW = 16 * 8192, half = NW / 2;
    for (int wk = cu * NTHR + tid; wk < half; wk += ncu * NTHR) {
        const int wa = wk, wb = wk + half;
        const int bha = wa >> 13, pa = wa & 8191, bhb = wb >> 13, pb = wb & 8191; const int da = (pa & 31) * 4, db = (pb & 31) * 4;
        float a0 = 0.f, a1 = 0.f, a2 = 0.f, a3 = 0.f, b0 = 0.f, b1 = 0.f, b2 = 0.f, b3 = 0.f;
        const size_t basea = (size_t)bha * 64 * 32768 + (size_t)pa * 4, baseb = (size_t)bhb * 64 * 32768 + (size_t)pb * 4;
#pragma unroll 8
        for (int n = 0; n < 64; ++n) {
            const v2u ua = *(const v2u*)(Ut + basea + (size_t)n * 32768), ub = *(const v2u*)(Ut + baseb + (size_t)n * 32768);
            const f32x4 dda = *(const f32x4*)(dv + (size_t)(bha * 64 + n) * 128 + da), ddb = *(const f32x4*)(dv + (size_t)(bhb * 64 + n) * 128 + db);
            v2u oa, ob; oa.x = pk2(a0, a1); oa.y = pk2(a2, a3); ob.x = pk2(b0, b1); ob.y = pk2(b2, b3);
            *(v2u*)(St + basea + (size_t)n * 32768) = oa; *(v2u*)(St + baseb + (size_t)n * 32768) = ob;
            a0 = a0 * dda[0] + bf_lo(ua.x); a1 = a1 * dda[1] + bf_hi(ua.x); a2 = a2 * dda[2] + bf_lo(ua.y); a3 = a3 * dda[3] + bf_hi(ua.y);
            b0 = b0 * ddb[0] + bf_lo(ub.x); b1 = b1 * ddb[1] + bf_hi(ub.x); b2 = b2 * ddb[2] + bf_lo(ub.y); b3 = b3 * ddb[3] + bf_hi(ub.y);
        }
    }
}
__device__ __forceinline__ void gla_step3(const Params& P, int l, LAS unsigned char* lds, int item, int tid) {
    const int bh = item >> 6, n = item & 63, b = bh >> 2, h = bh & 3; const int t0 = b * SEQ + n * 64;
    const bf16* z = (const bf16*)(P.ws + WS_Z); const float* zs = (const float*)(P.ws + WS_ZS);
    LAS unsigned char* QT = lds; LAS unsigned char* KT = lds + 17408; LAS unsigned char* VT = lds + 34816; LAS unsigned char* ST = lds + 69632; LAS unsigned char* PL = lds + 139264;
    LAS float* GD = (LAS float*)(lds + 139264); LAS float* TOT = (LAS float*)(lds + 139264 + 4096); LAS float* PART = (LAS float*)(lds + 148480);
    const int d = tid & 127, rg = tid >> 7;
    const int lane = tid & 63, w = tid >> 6, i = lane & 15, quad = lane >> 4; const int e0 = w * 32;
    f32x4 gdr = (f32x4){0.f, 0.f, 0.f, 0.f}; if (tid < 256) gdr = *(const f32x4*)(zs + (size_t)t0 * 32 + (tid >> 2) * 32 + (tid & 3) * 4);
    float wv[16]; { const float* wup = P.w_gk_up + (size_t)l * 16 * 512 + h * 128;
#pragma unroll
      for (int r = 0; r < 16; ++r) wv[r] = wup[r * 512 + d]; }
    const float bias = P.b_gk[l * 512 + h * 128 + d];
    bf16 qraw[16], kraw[16];
#pragma unroll
    for (int c = 0; c < 16; ++c) { const size_t zo = (size_t)(t0 + rg * 16 + c) * ZP + h * 128 + d; qraw[c] = z[zo + ZC_GQ]; kraw[c] = z[zo + ZC_GK]; }
    v4u vr[4]; load_v(z + (size_t)t0 * ZP + ZC_GV + h * 256, tid, vr);
    bf16x8 sfr[2][4];
    { const bf16* St = (const bf16*)(P.ws + WS_Y) + (size_t)item * 32768;
#pragma unroll
      for (int et = 0; et < 2; ++et)
#pragma unroll
          for (int ks = 0; ks < 4; ++ks) sfr[et][ks] = *(const bf16x8*)(St + (size_t)(e0 + et * 16 + i) * 128 + ks * 32 + quad * 8); }
    __syncthreads();
    if (tid < 256) *(LAS f32x4*)(GD + (tid >> 2) * 16 + (tid & 3) * 4) = gdr;
    store_v(VT, tid, vr);
    __syncthreads();
    float bv[16], blast;
    gla_decay(GD, TOT, tid, wv, bias, bv, blast);
#pragma unroll
    for (int c = 0; c < 16; ++c) { const int row = rg * 16 + c;
        const float q = bf2f(qraw[c]) * 0.08838834764831845f * __expf(bv[c]), k = bf2f(kraw[c]) * __expf(-bv[c]);
        *(LAS bf16*)(QT + row * 272 + d * 2) = (bf16)f2bf(q); *(LAS bf16*)(KT + row * 272 + d * 2) = (bf16)f2bf(k); }
    __syncthreads();
    { const int cpt = w & 3;
#pragma unroll
      for (int hf = 0; hf < 2; ++hf) { const int ct = 2 * (w >> 2) + hf; f32x4 a4 = (f32x4){0.f, 0.f, 0.f, 0.f};
#pragma unroll
          for (int ks = 0; ks < 4; ++ks) { const bf16x8 ka = *(const LAS bf16x8*)(KT + (cpt * 16 + i) * 272 + (ks * 32 + quad * 8) * 2), qb = *(const LAS bf16x8*)(QT + (ct * 16 + i) * 272 + (ks * 32 + quad * 8) * 2);
              a4 = MFMA16(ka, qb, a4); }
          const int cq = ct * 16 + i, ck = cpt * 16 + quad * 4;
          v2u o; o.x = pk2(ck <= cq ? a4[0] : 0.f, ck + 1 <= cq ? a4[1] : 0.f); o.y = pk2(ck + 2 <= cq ? a4[2] : 0.f, ck + 3 <= cq ? a4[3] : 0.f);
          *(LAS v2u*)(PL + cq * 144 + ck * 2) = o; } }
    __syncthreads();
    f32x4 acc[4][2];
#pragma unroll
    for (int ct = 0; ct < 4; ++ct) { acc[ct][0] = (f32x4){0.f, 0.f, 0.f, 0.f}; acc[ct][1] = (f32x4){0.f, 0.f, 0.f, 0.f}; }
#pragma unroll
    for (int ks = 0; ks < 4; ++ks) { const bf16x8 s0 = sfr[0][ks], s1 = sfr[1][ks];
#pragma unroll
        for (int ct = 0; ct < 4; ++ct) { const bf16x8 qa = *(const LAS bf16x8*)(QT + (ct * 16 + i) * 272 + (ks * 32 + quad * 8) * 2); acc[ct][0] = MFMA16(qa, s0, acc[ct][0]); acc[ct][1] = MFMA16(qa, s1, acc[ct][1]); } }
#pragma unroll
    for (int ks = 0; ks < 2; ++ks) { const LAS unsigned char* p0 = VT + (ks * 32 + quad * 8 + (i >> 2)) * 544 + (e0 + 4 * (i & 3)) * 2;
        const bf16x8 v0 = cat8(trread(p0), trread(p0 + 4 * 544)), v1 = cat8(trread(p0 + 32), trread(p0 + 32 + 4 * 544));
#pragma unroll
        for (int ct = 0; ct < 4; ++ct) { const bf16x8 pa = *(const LAS bf16x8*)(PL + (ct * 16 + i) * 144 + (ks * 32 + quad * 8) * 2); acc[ct][0] = MFMA16(pa, v0, acc[ct][0]); acc[ct][1] = MFMA16(pa, v1, acc[ct][1]); } }
    bf16 gra[4][4], grb[4][4];
#pragma unroll
    for (int ct = 0; ct < 4; ++ct)
#pragma unroll
        for (int j = 0; j < 4; ++j) { const size_t tt = (size_t)(t0 + ct * 16 + quad * 4 + j); gra[ct][j] = z[tt * ZP + ZC_GG + h * 256 + e0 + i]; grb[ct][j] = z[tt * ZP + ZC_GG + h * 256 + e0 + 16 + i]; }
#pragma unroll
    for (int ct = 0; ct < 4; ++ct)
#pragma unroll
        for (int j = 0; j < 4; ++j) { float s = acc[ct][0][j] * acc[ct][0][j] + acc[ct][1][j] * acc[ct][1][j];
            s = row16_sum(s);
            if (i == 0) PART[w * 64 + ct * 16 + quad * 4 + j] = s; }
    __syncthreads();
    if (tid < 64) { float s = 0.f;
#pragma unroll
        for (int ww = 0; ww < 8; ++ww) s += PART[ww * 64 + tid];
        PART[512 + tid] = rsqrtf(s * (1.0f / 256.0f) + 1e-6f); }
    __syncthreads();
    const float* gain = P.gla_norm_gain + l * 256; const float g0 = gain[e0 + i], g1 = gain[e0 + 16 + i];
    bf16* mix = (bf16*)(P.ws + WS_XB);
#pragma unroll
    for (int ct = 0; ct < 4; ++ct)
#pragma unroll
        for (int j = 0; j < 4; ++j) { const int c = ct * 16 + quad * 4 + j;
            const float r = PART[512 + c]; const size_t tt = (size_t)(t0 + c);
            const float ga = bf2f(gra[ct][j]), gb = bf2f(grb[ct][j]);
            mix[tt * 2048 + h * 256 + e0 + i] = (bf16)f2bf(acc[ct][0][j] * r * g0 * ga); mix[tt * 2048 + h * 256 + e0 + 16 + i] = (bf16)f2bf(acc[ct][1][j] * r * g1 * gb); }
}
__device__ __forceinline__ void mem_attn(const Params& P, int l, LAS unsigned char* lds, int item, int tid) {
    const int bh = item >> 3, qblk2 = (item & 7) * 2, b = bh >> 2, h = bh & 3;
    const bf16* z = (const bf16*)(P.ws + WS_Z); const bf16* mkv = (const bf16*)(P.ws + WS_MKV); bf16* mix = (bf16*)(P.ws + WS_XB);
    LAS unsigned char* KS = lds; LAS unsigned char* VS = lds + 69632;
    v4u kr[8], vr[8];
#pragma unroll
    for (int i = 0; i < 8; ++i) { const int idx = tid + 512 * i, key = idx >> 4, ch = idx & 15; const bf16* src = mkv + (size_t)(b * MEMLEN + key) * 2048 + l * 1024 + h * 128 + ch * 8; kr[i] = *(const v4u*)src; vr[i] = *(const v4u*)(src + 512); }
    __syncthreads();
#pragma unroll
    for (int i = 0; i < 8; ++i) { const int idx = tid + 512 * i, key = idx >> 4, ch = idx & 15; *(LAS v4u*)(KS + key * 272 + ch * 16) = kr[i]; *(LAS v4u*)(VS + key * 288 + ch * 16) = vr[i]; }
    __syncthreads();
    const int lane = tid & 63, w = tid >> 6, i = lane & 15, quad = lane >> 4;
    for (int trip = 0; trip < 2; ++trip) {
        const int q0 = (qblk2 + trip) * 256 + w * 32; const size_t tt0 = (size_t)(b * SEQ + q0 + i), tt1 = tt0 + 16;
        bf16x8 qf0[4], qf1[4];
#pragma unroll
        for (int ks = 0; ks < 4; ++ks) { qf0[ks] = *(const bf16x8*)(z + tt0 * ZP + ZC_MQ + h * 128 + ks * 32 + quad * 8); qf1[ks] = *(const bf16x8*)(z + tt1 * ZP + ZC_MQ + h * 128 + ks * 32 + quad * 8); }
        f32x4 sa[16], sb[16];
#pragma unroll
        for (int kt = 0; kt < 16; ++kt) { sa[kt] = (f32x4){0.f, 0.f, 0.f, 0.f}; sb[kt] = (f32x4){0.f, 0.f, 0.f, 0.f};
#pragma unroll
            for (int ks = 0; ks < 4; ++ks) { const bf16x8 ka = *(const LAS bf16x8*)(KS + (kt * 16 + i) * 272 + (ks * 32 + quad * 8) * 2); sa[kt] = MFMA16(ka, qf0[ks], sa[kt]); sb[kt] = MFMA16(ka, qf1[ks], sb[kt]); }
            if (kt & 1) __builtin_amdgcn_sched_barrier(0); }
        float mxa = -INFINITY, mxb = -INFINITY;
#pragma unroll
        for (int kt = 0; kt < 16; ++kt) { mxa = fmaxf(fmaxf(fmaxf(sa[kt][0], sa[kt][1]), fmaxf(sa[kt][2], sa[kt][3])), mxa); mxb = fmaxf(fmaxf(fmaxf(sb[kt][0], sb[kt][1]), fmaxf(sb[kt][2], sb[kt][3])), mxb); }
        mxa = fmaxf(mxa, __shfl_xor(mxa, 16)); mxa = fmaxf(mxa, __shfl_xor(mxa, 32)); mxb = fmaxf(mxb, __shfl_xor(mxb, 16)); mxb = fmaxf(mxb, __shfl_xor(mxb, 32));
        const float sc = 0.08838834764831845f * 1.4426950408889634f; float lsa = 0.f, lsb = 0.f;
        bf16x8 pa[8], pbb[8];
#pragma unroll
        for (int s = 0; s < 8; ++s) { float p[8], r[8];
#pragma unroll
            for (int j = 0; j < 4; ++j) { p[j] = __builtin_amdgcn_exp2f((sa[2 * s][j] - mxa) * sc); p[4 + j] = __builtin_amdgcn_exp2f((sa[2 * s + 1][j] - mxa) * sc); r[j] = __builtin_amdgcn_exp2f((sb[2 * s][j] - mxb) * sc); r[4 + j] = __builtin_amdgcn_exp2f((sb[2 * s + 1][j] - mxb) * sc); }
#pragma unroll
            for (int j = 0; j < 8; ++j) { lsa += p[j]; lsb += r[j]; }
            v4u pw; pw.x = pk2(p[0], p[1]); pw.y = pk2(p[2], p[3]); pw.z = pk2(p[4], p[5]); pw.w = pk2(p[6], p[7]); pa[s] = __builtin_bit_cast(bf16x8, pw);
            v4u rw; rw.x = pk2(r[0], r[1]); rw.y = pk2(r[2], r[3]); rw.z = pk2(r[4], r[5]); rw.w = pk2(r[6], r[7]); pbb[s] = __builtin_bit_cast(bf16x8, rw); }
        lsa += __shfl_xor(lsa, 16); lsa += __shfl_xor(lsa, 32); lsb += __shfl_xor(lsb, 16); lsb += __shfl_xor(lsb, 32);
        f32x4 oa[8], ob[8];
#pragma unroll
        for (int et = 0; et < 8; ++et) { oa[et] = (f32x4){0.f, 0.f, 0.f, 0.f}; ob[et] = (f32x4){0.f, 0.f, 0.f, 0.f}; }
#pragma unroll
        for (int s = 0; s < 8; ++s) { const LAS unsigned char* vp = VS + (32 * s + quad * 4 + (i >> 2)) * 288 + (4 * (i & 3)) * 2;
#pragma unroll
            for (int et = 0; et < 8; ++et) { const bf16x8 va = cat8(trread(vp + et * 32), trread(vp + et * 32 + 16 * 288)); oa[et] = MFMA16(va, pa[s], oa[et]); ob[et] = MFMA16(va, pbb[s], ob[et]); }
            __builtin_amdgcn_sched_barrier(0); }
        const float rla = 1.0f / lsa, rlb = 1.0f / lsb;
#pragma unroll
        for (int et = 0; et < 8; ++et) { const int e = et * 16 + quad * 4;
            const v2u g0 = *(const v2u*)(z + tt0 * ZP + ZC_MG + h * 128 + e), g1 = *(const v2u*)(z + tt1 * ZP + ZC_MG + h * 128 + e);
            v2u o; o.x = pk2(oa[et][0] * rla * bf_lo(g0.x), oa[et][1] * rla * bf_hi(g0.x)); o.y = pk2(oa[et][2] * rla * bf_lo(g0.y), oa[et][3] * rla * bf_hi(g0.y));
            *(v2u*)(mix + tt0 * 2048 + 1536 + h * 128 + e) = o;
            v2u o2; o2.x = pk2(ob[et][0] * rlb * bf_lo(g1.x), ob[et][1] * rlb * bf_hi(g1.x)); o2.y = pk2(ob[et][2] * rlb * bf_lo(g1.y), ob[et][3] * rlb * bf_hi(g1.y));
            *(v2u*)(mix + tt1 * 2048 + 1536 + h * 128 + e) = o2; }
    }
}
__device__ __forceinline__ void fox_seg(const Params& P, int l, int item, LAS float* scr, int tid) {
    const int bh = item >> 3, seg = item & 7, b = bh >> 3, h = bh & 7, pos = seg * 512 + tid;
    const float* zs = (const float*)(P.ws + WS_ZS); const bf16* z = (const bf16*)(P.ws + WS_Z); float* ft = (float*)(P.ws + WS_FOXT);
    const float lf = logsig(zs[(size_t)(b * SEQ + pos) * 32 + 16 + h] + P.b_f[l * 8 + h]);
    const bf16* zr = z + (size_t)(b * SEQ + pos) * ZP + h * 64; float sq = 0.f, sk = 0.f;
#pragma unroll
    for (int c = 0; c < 8; ++c) { const v4u a = *(const v4u*)(zr + ZC_FQ + c * 8), k4 = *(const v4u*)(zr + ZC_FK + c * 8);
#pragma unroll
        for (int e = 0; e < 4; ++e) { const float a0 = bf_lo(a[e]), a1 = bf_hi(a[e]), k0 = bf_lo(k4[e]), k1 = bf_hi(k4[e]); sq += a0 * a0 + a1 * a1; sk += k0 * k0 + k1 * k1; } }
    const int lane = tid & 63, w = tid >> 6; float inc = lf;
#pragma unroll
    for (int o = 1; o < 64; o <<= 1) { const float t = __shfl_up(inc, o); if (lane >= o) inc += t; }
#pragma unroll
    for (int o = 1; o < 64; o <<= 1) { sq = fmaxf(sq, __shfl_xor(sq, o)); sk = fmaxf(sk, __shfl_xor(sk, o)); }
    __syncthreads();
    if (lane == 63) { scr[w] = inc; scr[8 + w] = sq; scr[16 + w] = sk; }
    __syncthreads();
    float off = 0.f;
#pragma unroll
    for (int ww = 0; ww < 8; ++ww) if (ww < w) off += scr[ww];
    ft[FT_CBL + bh * 4096 + pos] = inc + off;
    if (tid == 511) ft[FT_SEG + bh * 8 + seg] = inc + off;
    if (tid == 0) { ft[FT_QNB + bh * 16 + 2 * seg] = fmaxf(fmaxf(scr[8], scr[9]), fmaxf(scr[10], scr[11])); ft[FT_QNB + bh * 16 + 2 * seg + 1] = fmaxf(fmaxf(scr[12], scr[13]), fmaxf(scr[14], scr[15]));
        float km = 0.f;
#pragma unroll
        for (int ww = 0; ww < 8; ++ww) km = fmaxf(km, scr[16 + ww]);
        ft[FT_KNS + bh * 8 + seg] = km; }
}
__device__ __forceinline__ void fox_bias(const Params& P, int bh, LAS float* cb, LAS float* wtot, int tid) {
    const float* ft = (const float*)(P.ws + WS_FOXT); const int w = tid >> 6;
    float off = 0.f, km = 0.f;
#pragma unroll
    for (int sg = 0; sg < 8; ++sg) { const float t = ft[FT_SEG + bh * 8 + sg]; if (sg < w) off += t; km = fmaxf(km, ft[FT_KNS + bh * 8 + sg]); }
    const f32x4 c0 = *(const f32x4*)(ft + FT_CBL + bh * 4096 + tid * 8), c1 = *(const f32x4*)(ft + FT_CBL + bh * 4096 + tid * 8 + 4);
    *(LAS f32x4*)(cb + tid * 8) = (c0 + off) * -1.4426950408889634f; *(LAS f32x4*)(cb + tid * 8 + 4) = (c1 + off) * -1.4426950408889634f;
    if (tid < 16) wtot[8 + tid] = ft[FT_QNB + bh * 16 + tid];
    if (tid == 16) wtot[24] = km;
    __syncthreads();
}
#define FOX_MARGIN 50.0f
__device__ __forceinline__ int fox_skip(const LAS float* cb, const LAS float* wtot, int qb, int tid) {
    const float qn = wtot[8 + qb], kn = wtot[24];
    const float smax = sqrtf(qn) * sqrtf(kn) * 1.0001f + 1e-3f;
    const int lane = tid & 63; const float thr = cb[qb * 256] - 2.0f * smax - FOX_MARGIN;
    const unsigned long long m = __ballot(cb[lane * 64 + 63] <= thr);
    int t0 = __builtin_popcountll(m) & ~1; const int nt = 4 * qb + 4; if (t0 > nt - 4) t0 = nt - 4;
    return __builtin_amdgcn_readfirstlane(t0);
}
__device__ __forceinline__ void side_gemm(const Params& P, int l, int tid, int G) {
    const bf16* XBp = (const bf16*)(P.ws + WS_XB); const bf16* Wt = (const bf16*)(P.ws + WS_WIN) + (size_t)l * NZ * 2048 + (size_t)12288 * 2048;
    float* zs = (float*)(P.ws + WS_ZS);
    const int lane = tid & 63, w = tid >> 6, i = lane & 15, quad = lane >> 4;
    for (int blk = blockIdx.x; blk < T / 64; blk += G) {
        const int row0 = blk * 64 + (w >> 1) * 16, ct = w & 1;
        const bf16* ap = XBp + (size_t)(row0 + i) * 2048 + quad * 8; const bf16* bp = Wt + (size_t)(ct * 16 + i) * 2048 + quad * 8;
        f32x4 acc = (f32x4){0.f, 0.f, 0.f, 0.f};
#pragma unroll 16
        for (int ks = 0; ks < 64; ++ks) { const bf16x8 a = *(const bf16x8*)(ap + ks * 32), b = *(const bf16x8*)(bp + ks * 32); acc = MFMA16(a, b, acc); }
#pragma unroll
        for (int j = 0; j < 4; ++j) { const int row = row0 + quad * 4 + j; zs[(size_t)row * 32 + ct * 16 + i] = acc[j]; }
    }
}
__device__ __forceinline__ void final_norm(const Params& P, int tid, int G) {
    const int lane = tid & 63, wave = tid >> 6; const float* ss = (const float*)(P.ws + WS_SS) + 2 * T;
    for (int m = blockIdx.x * NWAVES + wave; m < T; m += G * NWAVES) { const float r = rsqrtf(ss[m] * (1.0f / 2048.0f) + 1e-6f);
        f32x4* xr = (f32x4*)(P.out + (size_t)m * DM) + lane; const f32x4* gr = (const f32x4*)P.final_gain + lane;
#pragma unroll
        for (int j = 0; j < 8; ++j) { const f32x4 v = xr[64 * j], g = gr[64 * j]; xr[64 * j] = v * r * g; } }
}

#ifndef P1_ALIGN
#define P1_ALIGN true
#endif
#ifndef P1_SP2
#define P1_SP2 true
#endif
#ifndef REPEAT_MASK
#define REPEAT_MASK 0
#endif
__global__ void __launch_bounds__(NTHR, 2) fwd_mega(Params P) {
    extern __shared__ __attribute__((aligned(16))) unsigned char lds_raw[];
    cg::grid_group grid = cg::this_grid();
    LAS unsigned char* lds = (LAS unsigned char*)lds_raw;
    const int tid = threadIdx.x, G = gridDim.x, bx = blockIdx.x;
    unsigned char* ws = P.ws;
    volatile LAS unsigned* bst = (volatile LAS unsigned*)(lds + LDS_BYTES - 16);
    if (tid < 4) bst[tid] = 0u;
    __syncthreads();
    XcdBarrier xbar = xcd_barrier_post((unsigned*)(ws + WS_CTL), bst);
    bf16* XB = (bf16*)(ws + WS_XB); bf16* Z = (bf16*)(ws + WS_Z); float* ZS = (float*)(ws + WS_ZS); float* SS = (float*)(ws + WS_SS);

    for (int rep_ = 0; rep_ < 1 + ((REPEAT_MASK >> 7) & 1); ++rep_)
    { int tp = tid; asm volatile("" : "+v"(tp)); phase_prologue(P, lds, tp, G); }
    if (P.out == nullptr) grid.sync();
    xcd_barrier(xbar);
    for (int l = 0; l < DEPTH; ++l) {
        for (int rep_ = 0; rep_ < 1 + ((REPEAT_MASK >> 5) & 1); ++rep_)
        { pg8::Gemm g{XB, (const bf16*)(ws + WS_WIN) + (size_t)l * NZ * 2048, T, ZP, 2048}; pg8::StaticOrder S; S.init(T, ZP, G, bx);
          pg8::EpiZ E{Z, ZP, 0};
          pg8::gemm_phase<pg8::EpiZ, pg8::StaticOrder, P1_ALIGN, P1_SP2>(lds, g, S, E); }
        { int tp = tid; asm volatile("" : "+v"(tp)); side_gemm(P, l, tp, G); }
        if (l == 0) { pg8::Gemm g{(const bf16*)(ws + WS_MEMB), (const bf16*)(ws + WS_WKV), MROWS, 2048, 2048}; pg8::TailOrder S{bx, G - 32, 4};
          pg8::EpiZ E{(bf16*)(ws + WS_MKV), 2048, 1};
          pg8::gemm_phase<pg8::EpiZ, pg8::TailOrder, true, true>(lds, g, S, E); }
        xcd_barrier(xbar);
        for (int rep_ = 0; rep_ < 1 + ((REPEAT_MASK >> 0) & 1); ++rep_)
        { G1Pre R1; int tp = tid; asm volatile("" : "+v"(tp));
          if (bx < 1024) gla_step1_pre(P, bx, tp, R1);
          for (int it = bx; it < 1024; it += G) { asm volatile("" : "+v"(tp)); gla_step1(P, l, lds, it, it + G < 1024 ? it + G : -1, tp, R1); } }
        xcd_barrier(xbar);
        { const int hg = G >> 1;
          if (bx < hg) { int tp = tid; asm volatile("" : "+v"(tp)); gla_scan(P, tp, bx, hg);
              for (int it = bx; it < 256; it += hg) { asm volatile("" : "+v"(tp)); fox_seg(P, l, it, (LAS float*)lds, tp); } }
          else for (int it = bx - hg; it < 128; it += G - hg) { int tp = tid; asm volatile("" : "+v"(tp)); mem_attn(P, l, lds, it, tp); } }
        xcd_barrier(xbar);
        for (int rep_ = 0; rep_ < 1 + ((REPEAT_MASK >> 3) & 1); ++rep_)
        { const int vcu = (G % 8 == 0) ? (bx % 8) * (G / 8) + bx / 8 : bx;
          for (int pr = vcu; pr < 256; pr += G) { const int bh = pr >> 3, s = pr & 7, b = bh >> 3, h = bh & 7;
              __syncthreads();
              { int tp = tid; asm volatile("" : "+v"(tp)); fox_bias(P, bh, (LAS float*)(lds + 86016), (LAS float*)(lds + 102400), tp); }
              for (int k = 0; k < 2; ++k) { const int qb = k == 0 ? 15 - s : s; const int t0s = fox_skip((const LAS float*)(lds + 86016), (const LAS float*)(lds + 102400), qb, tid);
                  attn_body::attn_unit<40>(b, h, qb, (const attn_body::bf16*)(Z + ZC_FQ), (const attn_body::bf16*)(Z + ZC_FK), (const attn_body::bf16*)(Z + ZC_FV), (attn_body::bf16*)(XB + 1024),
                                          (const attn_body::bf16*)(Z + ZC_FG), (attn_body::lds_f4p)(lds + 86016), t0s, (char*)lds_raw); } } }
        for (int rep_ = 0; rep_ < 1 + ((REPEAT_MASK >> 4) & 1); ++rep_)
        for (int it = bx; it < 1024; it += G) { int tp = tid; asm volatile("" : "+v"(tp)); gla_step3(P, l, lds, it, tp); }
        xcd_barrier(xbar);
        for (int rep_ = 0; rep_ < 1 + ((REPEAT_MASK >> 6) & 1); ++rep_)
        { pg8::Gemm g{XB, (const bf16*)(ws + WS_WBR) + (size_t)l * 2048 * 2048, T, 2048, 2048}; pg8::StaticOrder S; S.init(T, 2048, G, bx);
          pg8::EpiY E{(bf16*)(ws + WS_Y), Z + ZC_MERGE, ZP};
          pg8::gemm_phase<pg8::EpiY, pg8::StaticOrder, true, true>(lds, g, S, E); }
        xcd_barrier(xbar);
        { pg8::Gemm g{(const bf16*)(ws + WS_Y), (const bf16*)(ws + WS_WOUT) + (size_t)l * 2048 * 2048, T, 2048, 2048}; pg8::StaticOrder S; S.init(T, 2048, G, bx);
          unsigned* pcnt = (unsigned*)(ws + WS_CTL + 16384) + l * 4096;
          if (G == 256 && l == DEPTH - 1) { pg8::EpiXF<true> E{P.out, P.out, nullptr, SS + (l + 1) * T, pcnt, P.final_gain};
              pg8::gemm_phase<pg8::EpiXF<true>, pg8::StaticOrder, true, true>(lds, g, S, E); }
          else if (G == 256) { pg8::EpiXF<false> E{l == 0 ? P.x : P.out, P.out, XB, SS + (l + 1) * T, pcnt, nullptr};
              pg8::gemm_phase<pg8::EpiXF<false>, pg8::StaticOrder, true, true>(lds, g, S, E); }
          else { pg8::EpiX E{l == 0 ? P.x : P.out, P.out, l == DEPTH - 1 ? nullptr : XB, SS + (l + 1) * T};
              pg8::gemm_phase<pg8::EpiX, pg8::StaticOrder, true, true>(lds, g, S, E); } }
        if (!(l == DEPTH - 1 && G == 256)) xcd_barrier(xbar);
        if (G != 256 && l < DEPTH - 1) { int tp = tid; asm volatile("" : "+v"(tp)); rescale_rows(XB, SS + (l + 1) * T, tp, G); xcd_barrier(xbar); }
    }
    if (G == 256) return;
#ifdef EXTRA_SYNCS
    for (int k_ = 0; k_ < EXTRA_SYNCS; ++k_) xcd_barrier(xbar);
#endif
    { int tp = tid; asm volatile("" : "+v"(tp)); final_norm(P, tp, G); }
}

extern "C" void kernel_launch(void* const* d_in, const int* in_sizes, int n_in, void* d_out, int out_size, void* d_ws, size_t ws_size, hipStream_t stream) {
    static int grid = 0;
    if (grid == 0) {
        if (n_in != 13 || ws_size < WS_END) { fprintf(stderr, "kernel_launch: need 13 inputs and >= %zu bytes of workspace (got %d, %zu)\n", (size_t)WS_END, n_in, ws_size); grid = -1; return; }
        int dev = 0, cus = 0, per_cu = 0;
        (void)hipGetDevice(&dev); (void)hipDeviceGetAttribute(&cus, hipDeviceAttributeMultiprocessorCount, dev);
        if (hipFuncSetAttribute((const void*)fwd_mega, hipFuncAttributeMaxDynamicSharedMemorySize, LDS_BYTES) != hipSuccess) { fprintf(stderr, "kernel_launch: hipFuncSetAttribute failed\n"); grid = -1; return; }
        if (hipOccupancyMaxActiveBlocksPerMultiprocessor(&per_cu, (const void*)fwd_mega, NTHR, LDS_BYTES) != hipSuccess || per_cu < 1) { fprintf(stderr, "kernel_launch: occupancy query says %d blocks/CU\n", per_cu); per_cu = 1; }
        (void)hipGetLastError();
        grid = cus;
    }
    if (grid < 0) return;
    Params p{};
    p.x = (const float*)d_in[0]; p.mem = (const float*)d_in[1]; p.norm_gain = (const float*)d_in[2]; p.w_in = (const float*)d_in[3]; p.w_gk_up = (const float*)d_in[4];
    p.b_gk = (const float*)d_in[5]; p.gla_norm_gain = (const float*)d_in[6]; p.b_f = (const float*)d_in[7]; p.mem_norm_gain = (const float*)d_in[8]; p.w_mem_kv = (const float*)d_in[9];
    p.w_branch = (const float*)d_in[10]; p.w_out = (const float*)d_in[11]; p.final_gain = (const float*)d_in[12];
    p.out = (float*)d_out; p.ws = (unsigned char*)d_ws;
    if (hipMemsetAsync((char*)d_ws + WS_CTL, 0, CTL_ZERO_BYTES, stream) != hipSuccess) { fprintf(stderr, "kernel_launch: memset failed\n"); return; }
    void* args[] = {&p};
    hipError_t e = hipLaunchCooperativeKernel((const void*)fwd_mega, dim3(grid), dim3(NTHR), args, LDS_BYTES, stream);
    if (e != hipSuccess) fprintf(stderr, "kernel_launch: cooperative launch failed: %s (grid %d)\n", hipGetErrorString(e), grid);
}
```
